# Optimizing an MI355X kernel written in HIP

```python
import math
import jax, jax.numpy as jnp
from jax import lax
import numpy as np

D_MODEL = 2048
BATCH = 1
SEQ = 8192
DEPTH = 1

POOL_WIDTH = D_MODEL // 2
POOL_WINDOWS = (2, 4, 8, 16)
N_POOL_GROUPS = len(POOL_WINDOWS)
POOL_GROUP = POOL_WIDTH // N_POOL_GROUPS
N_HEADS = 16
N_KV_GROUPS = 4
HEADS_PER_GROUP = N_HEADS // N_KV_GROUPS
D_QK = 96
D_V = 64
ROT_DIM = D_QK // 4
ROPE_THETA = 500000.0
CMP_LEN = 32
CMP_STRIDE = 16
CMP_HID_K = 4 * D_QK
CMP_HID_V = 4 * D_V
SLC_LEN = 64
N_SELECT = 16
WINDOW = 512
Q_BLOCK = 128
KV_K = N_KV_GROUPS * D_QK
KV_V = N_KV_GROUPS * D_V
N_EXPERTS = 64
TOP_K = 8
N_EXPERT_GROUPS = 8
TOPK_GROUPS = 4
D_EXPERT = D_MODEL // 4
D_SHARED = D_EXPERT
ROUTED_SCALE = 2.5
MOE_BLOCK = 128
RMS_EPS = 1e-6
NEG_INF = -1e30
SEL_FORCE = 1e30
IN_SIZES = (POOL_WIDTH, N_HEADS * D_QK, KV_K, KV_V, KV_K, KV_V, KV_K, KV_V, 3 * N_HEADS, 2 * D_MODEL)
IN_COLS = sum(IN_SIZES)

kernel_name = 'hybrid_pool_nsa_moe_block'


def rms_norm(x, g):
    x32 = x.astype(jnp.float32)
    y = x32 * lax.rsqrt(jnp.mean(x32 * x32, axis=-1, keepdims=True) + RMS_EPS)
    return (y * g.astype(jnp.float32)).astype(x.dtype)


def rope_partial(x, pos):
    half = ROT_DIM // 2
    inv = jnp.power(jnp.float32(ROPE_THETA), -jnp.arange(half, dtype=jnp.float32) * 2.0 / ROT_DIM)
    ang = pos.astype(jnp.float32)[..., None] * inv
    cos = jnp.cos(ang)[:, :, None, :]
    sin = jnp.sin(ang)[:, :, None, :]
    x32 = x.astype(jnp.float32)
    x1 = x32[..., :half]
    x2 = x32[..., half:ROT_DIM]
    out = jnp.concatenate([x1 * cos - x2 * sin, x2 * cos + x1 * sin, x32[..., ROT_DIM:]], axis=-1)
    return out.astype(x.dtype)


def multiscale_pool(u, pool_w, pool_scale):
    B, T, _ = u.shape
    u4 = u.astype(jnp.float32).reshape(B, T, N_POOL_GROUPS, POOL_GROUP)
    cs = jnp.pad(jnp.cumsum(u4, axis=1), ((0, 0), (1, 0), (0, 0), (0, 0)))
    win = jnp.asarray(POOL_WINDOWS, dtype=jnp.int32)
    t = jnp.arange(T, dtype=jnp.int32)
    lo_idx = jnp.maximum(t[:, None] + 1 - win[None, :], 0)
    lo = cs[:, lo_idx, jnp.arange(N_POOL_GROUPS)[None, :], :]
    count = jnp.minimum(t[:, None] + 1, win[None, :]).astype(jnp.float32)
    d = (cs[:, 1:] - lo) / count[None, :, :, None] - u4
    out = jnp.einsum('btgc,gce->btge', d, pool_w.astype(jnp.float32))
    out = out * pool_scale.astype(jnp.float32).reshape(N_POOL_GROUPS, POOL_GROUP)
    return out.reshape(B, T, POOL_WIDTH)


def cmp_to_slc_matrix(n_cmp, n_slc):
    cs = np.arange(n_cmp)[:, None] * CMP_STRIDE
    ss = np.arange(n_slc)[None, :] * SLC_LEN
    ov = np.clip(np.minimum(cs + CMP_LEN, ss + SLC_LEN) - np.maximum(cs, ss), 0, None)
    return jnp.asarray(ov / CMP_LEN, dtype=jnp.float32)


def compress(raw, pos_emb, w1, w2, d):
    B, T = raw.shape[0], raw.shape[1]
    n_cmp = (T - CMP_LEN) // CMP_STRIDE + 1
    blk = np.arange(n_cmp)[:, None] * CMP_STRIDE + np.arange(CMP_LEN)[None, :]
    xb = raw[:, blk] + pos_emb[None, None, :, None, :]
    xb = xb.transpose(0, 1, 3, 2, 4).reshape(B, n_cmp, N_KV_GROUPS, CMP_LEN * d)
    hid = jax.nn.silu(jnp.einsum('bngf,fh->bngh', xb, w1))
    return jnp.einsum('bngh,hd->bngd', hid, w2), blk[:, -1]


def nsa_attention(q_in, kc, vc, ks, vs, kw, vw, g_nsa, positions,
                  cmp_pos_k, cmp_k_w1, cmp_k_w2, cmp_pos_v, cmp_v_w1, cmp_v_w2):
    B, T, _ = q_in.shape
    R = HEADS_PER_GROUP
    G = N_KV_GROUPS
    q = rope_partial(q_in.reshape(B, T, N_HEADS, D_QK), positions) * (D_QK ** -0.5)
    q = q.reshape(B, T, G, R, D_QK).transpose(0, 2, 3, 1, 4)
    k_cmp, cmp_end = compress(kc.reshape(B, T, G, D_QK), cmp_pos_k, cmp_k_w1, cmp_k_w2, D_QK)
    v_cmp, _ = compress(vc.reshape(B, T, G, D_V), cmp_pos_v, cmp_v_w1, cmp_v_w2, D_V)
    k_cmp = rope_partial(k_cmp, positions[:, cmp_end]).transpose(0, 2, 1, 3)
    v_cmp = v_cmp.transpose(0, 2, 1, 3).astype(jnp.float32)
    cmp_end_j = jnp.asarray(cmp_end, dtype=jnp.int32)
    n_slc = T // SLC_LEN
    n_sel = min(N_SELECT, n_slc)
    cmp2slc = cmp_to_slc_matrix(cmp_end.shape[0], n_slc)
    ks_r = rope_partial(ks.reshape(B, T, G, D_QK), positions).transpose(0, 2, 1, 3)
    ks_blk = ks_r.reshape(B, G, n_slc, SLC_LEN, D_QK)
    vs_blk = vs.reshape(B, T, G, D_V).transpose(0, 2, 1, 3).reshape(B, G, n_slc, SLC_LEN, D_V)
    b_ix = jnp.arange(B)[:, None, None, None]
    g_ix = jnp.arange(G)[None, :, None, None]
    kw_r = rope_partial(kw.reshape(B, T, G, D_QK), positions).transpose(0, 2, 1, 3)
    kw_pad = jnp.pad(kw_r, ((0, 0), (0, 0), (WINDOW, 0), (0, 0)))
    vw_pad = jnp.pad(vw.reshape(B, T, G, D_V).transpose(0, 2, 1, 3), ((0, 0), (0, 0), (WINDOW, 0), (0, 0)))
    gates = jax.nn.sigmoid(g_nsa.astype(jnp.float32)).reshape(B, T, G, R, 3).transpose(0, 2, 3, 1, 4)

    def nsa_block(ci):
        s = ci * Q_BLOCK
        t = s + jnp.arange(Q_BLOCK, dtype=jnp.int32)
        qc = lax.dynamic_slice_in_dim(q, s, Q_BLOCK, axis=3)
        gc = lax.dynamic_slice_in_dim(gates, s, Q_BLOCK, axis=3)
        sc = jnp.einsum('bgrtd,bgnd->bgrtn', qc, k_cmp).astype(jnp.float32)
        ok_c = cmp_end_j[None, :] <= t[:, None]
        p_cmp = jax.nn.softmax(jnp.where(ok_c, sc, NEG_INF), axis=-1)
        p_cmp = p_cmp * jnp.any(ok_c, axis=-1)[:, None].astype(jnp.float32)
        o_cmp = jnp.einsum('bgrtn,bgnv->bgrtv', p_cmp, v_cmp)
        imp = jnp.einsum('bgrtn,nj->bgtj', p_cmp, cmp2slc)
        jj = jnp.arange(n_slc, dtype=jnp.int32)[None, :]
        cur = (t // SLC_LEN)[:, None]
        forced = (jj == 0) | (jj == cur) | (jj == cur - 1)
        valid = jj * SLC_LEN <= t[:, None]
        score = jnp.where(valid, jnp.where(forced, SEL_FORCE, imp), NEG_INF)
        top_val, top_idx = lax.top_k(score, n_sel)
        kb = ks_blk[b_ix, g_ix, top_idx]
        vb = vs_blk[b_ix, g_ix, top_idx].astype(jnp.float32)
        kpos = top_idx[..., None] * SLC_LEN + jnp.arange(SLC_LEN, dtype=jnp.int32)
        ok_s = (top_val[..., None] > 0.5 * NEG_INF) & (kpos <= t[None, None, :, None, None])
        ss = jnp.einsum('bgrtd,bgtkld->bgrtkl', qc, kb).astype(jnp.float32)
        ss = jnp.where(ok_s[:, :, None], ss, NEG_INF).reshape(B, G, R, Q_BLOCK, n_sel * SLC_LEN)
        p_s = jax.nn.softmax(ss, axis=-1).reshape(B, G, R, Q_BLOCK, n_sel, SLC_LEN)
        o_slc = jnp.einsum('bgrtkl,bgtklv->bgrtv', p_s, vb)
        kwc = lax.dynamic_slice_in_dim(kw_pad, s, Q_BLOCK + WINDOW, axis=2)
        vwc = lax.dynamic_slice_in_dim(vw_pad, s, Q_BLOCK + WINDOW, axis=2).astype(jnp.float32)
        wpos = (s - WINDOW + jnp.arange(Q_BLOCK + WINDOW, dtype=jnp.int32))[None, :]
        ok_w = (wpos <= t[:, None]) & (wpos > t[:, None] - WINDOW) & (wpos >= 0)
        sw = jnp.einsum('bgrtd,bgsd->bgrts', qc, kwc).astype(jnp.float32)
        p_w = jax.nn.softmax(jnp.where(ok_w, sw, NEG_INF), axis=-1)
        o_win = jnp.einsum('bgrts,bgsv->bgrtv', p_w, vwc)
        return gc[..., 0:1] * o_cmp + gc[..., 1:2] * o_slc + gc[..., 2:3] * o_win

    o = lax.map(nsa_block, jnp.arange(T // Q_BLOCK, dtype=jnp.int32))
    return o.transpose(1, 0, 4, 2, 3, 5).reshape(B, T, N_HEADS * D_V)


def token_mixer(h, positions, w_in, cmp_pos_k, cmp_k_w1, cmp_k_w2, cmp_pos_v, cmp_v_w1, cmp_v_w2,
                pool_w, pool_scale, w_pool_up, w_nsa_up, w_out):
    B, T, D = h.shape
    proj = jnp.einsum('btd,de->bte', h, w_in)
    split_at = [int(v) for v in np.cumsum(IN_SIZES)[:-1]]
    u_pool, q, kc, vc, ks, vs, kw, vw, g_nsa, g_merge = jnp.split(proj, split_at, axis=-1)
    a = multiscale_pool(u_pool, pool_w, pool_scale).astype(h.dtype)
    o = nsa_attention(q, kc, vc, ks, vs, kw, vw, g_nsa, positions,
                      cmp_pos_k, cmp_k_w1, cmp_k_w2, cmp_pos_v, cmp_v_w1, cmp_v_w2).astype(h.dtype)
    gm = jax.nn.sigmoid(g_merge.astype(jnp.float32)).reshape(B, T, 2, D)
    ya = jnp.einsum('btc,cd->btd', a, w_pool_up).astype(jnp.float32)
    yb = jnp.einsum('btc,cd->btd', o, w_nsa_up).astype(jnp.float32)
    y = (gm[:, :, 0] * ya + gm[:, :, 1] * yb).astype(h.dtype)
    return jnp.einsum('btd,de->bte', y, w_out)


def moe_ffn(h, w_router, router_bias, w_exp_gate, w_exp_up, w_exp_down, w_sh_gate, w_sh_up, w_sh_down):
    B, T, D = h.shape
    N = B * T
    xf = h.reshape(N, D)
    aff = jax.nn.sigmoid(jnp.einsum('nd,de->ne', xf.astype(jnp.float32), w_router.astype(jnp.float32)))
    biased = aff + router_bias.astype(jnp.float32)
    per_group = N_EXPERTS // N_EXPERT_GROUPS
    grp_score = lax.top_k(biased.reshape(N, N_EXPERT_GROUPS, per_group), 2)[0].sum(-1)
    _, grp_idx = lax.top_k(grp_score, TOPK_GROUPS)
    grp_keep = jnp.any(grp_idx[:, :, None] == jnp.arange(N_EXPERT_GROUPS)[None, None, :], axis=1)
    keep = jnp.repeat(grp_keep, per_group, axis=1)
    _, e_idx = lax.top_k(jnp.where(keep, biased, NEG_INF), TOP_K)
    w_sel = jnp.take_along_axis(aff, e_idx, axis=1)
    w_sel = w_sel / jnp.sum(w_sel, axis=-1, keepdims=True) * ROUTED_SCALE
    A = N * TOP_K
    e_flat = e_idx.reshape(A)
    tok_flat = jnp.repeat(jnp.arange(N, dtype=jnp.int32), TOP_K)
    w_flat = w_sel.reshape(A)
    order = jnp.argsort(e_flat)
    e_sorted = e_flat[order]
    counts = jnp.bincount(e_flat, length=N_EXPERTS)
    starts = jnp.cumsum(counts) - counts
    padded = (counts + MOE_BLOCK - 1) // MOE_BLOCK * MOE_BLOCK
    pend = jnp.cumsum(padded)
    pstart = pend - padded
    dest = pstart[e_sorted] + jnp.arange(A, dtype=jnp.int32) - starts[e_sorted]
    n_blocks = -(-A // MOE_BLOCK) + N_EXPERTS
    P = n_blocks * MOE_BLOCK
    tok_buf = jnp.full((P,), N, dtype=jnp.int32).at[dest].set(tok_flat[order])
    w_buf = jnp.zeros((P,), jnp.float32).at[dest].set(w_flat[order])
    blk_start = jnp.arange(n_blocks, dtype=pend.dtype) * MOE_BLOCK
    blk_expert = jnp.minimum(jnp.searchsorted(pend, blk_start, side='right'), N_EXPERTS - 1)
    x_pad = jnp.concatenate([xf, jnp.zeros((1, D), xf.dtype)], axis=0)

    def expert_block(args):
        rows, e = args
        xb = x_pad[rows]
        hid = jax.nn.silu(xb @ w_exp_gate[e]) * (xb @ w_exp_up[e])
        return hid @ w_exp_down[e]

    y_buf = lax.map(expert_block, (tok_buf.reshape(n_blocks, MOE_BLOCK), blk_expert))
    routed = jnp.zeros((N + 1, D), jnp.float32).at[tok_buf].add(
        y_buf.reshape(P, D).astype(jnp.float32) * w_buf[:, None])[:N]
    shared = (jax.nn.silu(xf @ w_sh_gate) * (xf @ w_sh_up)) @ w_sh_down
    return (routed + shared.astype(jnp.float32)).astype(h.dtype).reshape(B, T, D)


def setup_inputs(seed: int = 0) -> dict:
    key = jax.random.key(seed)
    k = jax.random.split(key, 32)
    L, D = DEPTH, D_MODEL
    f32 = jnp.float32

    def nrm(kk, shape, fan_in):
        return jax.random.normal(kk, shape, f32) * (fan_in ** -0.5)

    def gain(kk, n):
        return 1.0 + 0.05 * jax.random.normal(kk, (L, n), f32)

    return {
        'x': jax.random.normal(k[0], (BATCH, SEQ, D), f32),
        'c': jax.random.normal(k[1], (BATCH, D), f32),
        'positions': jnp.broadcast_to(jnp.arange(SEQ, dtype=jnp.int32), (BATCH, SEQ)),
        'w_ada': nrm(k[2], (L, D, 6 * D), D),
        'b_ada': 0.01 * jax.random.normal(k[3], (L, 6 * D), f32),
        'g_pre_mix': gain(k[4], D),
        'g_post_mix': gain(k[5], D),
        'g_pre_ffn': gain(k[6], D),
        'g_post_ffn': gain(k[7], D),
        'w_in': nrm(k[8], (L, D, IN_COLS), D),
        'cmp_pos_k': 0.1 * jax.random.normal(k[9], (L, CMP_LEN, D_QK), f32),
        'cmp_k_w1': nrm(k[10], (L, CMP_LEN * D_QK, CMP_HID_K), CMP_LEN * D_QK),
        'cmp_k_w2': nrm(k[11], (L, CMP_HID_K, D_QK), CMP_HID_K),
        'cmp_pos_v': 0.1 * jax.random.normal(k[12], (L, CMP_LEN, D_V), f32),
        'cmp_v_w1': nrm(k[13], (L, CMP_LEN * D_V, CMP_HID_V), CMP_LEN * D_V),
        'cmp_v_w2': nrm(k[14], (L, CMP_HID_V, D_V), CMP_HID_V),
        'pool_w': nrm(k[15], (L, N_POOL_GROUPS, POOL_GROUP, POOL_GROUP), POOL_GROUP),
        'pool_scale': gain(k[16], POOL_WIDTH),
        'w_pool_up': nrm(k[17], (L, POOL_WIDTH, D), POOL_WIDTH),
        'w_nsa_up': nrm(k[18], (L, N_HEADS * D_V, D), N_HEADS * D_V),
        'w_out': nrm(k[19], (L, D, D), D),
        'w_router': nrm(k[20], (L, D, N_EXPERTS), D),
        'router_bias': 0.01 * jax.random.normal(k[21], (L, N_EXPERTS), f32),
        'w_exp_gate': nrm(k[22], (L, N_EXPERTS, D, D_EXPERT), D),
        'w_exp_up': nrm(k[23], (L, N_EXPERTS, D, D_EXPERT), D),
        'w_exp_down': nrm(k[24], (L, N_EXPERTS, D_EXPERT, D), D_EXPERT),
        'w_sh_gate': nrm(k[25], (L, D, D_SHARED), D),
        'w_sh_up': nrm(k[26], (L, D, D_SHARED), D),
        'w_sh_down': nrm(k[27], (L, D_SHARED, D), D_SHARED),
    }


def reference(x, c, positions, w_ada, b_ada, g_pre_mix, g_post_mix, g_pre_ffn, g_post_ffn, w_in,
              cmp_pos_k, cmp_k_w1, cmp_k_w2, cmp_pos_v, cmp_v_w1, cmp_v_w2, pool_w, pool_scale,
              w_pool_up, w_nsa_up, w_out, w_router, router_bias, w_exp_gate, w_exp_up, w_exp_down,
              w_sh_gate, w_sh_up, w_sh_down):
    for l in range(DEPTH):
        mod = jnp.einsum('bd,de->be', jax.nn.silu(c), w_ada[l]) + b_ada[l]
        sh1, sc1, gt1, sh2, sc2, gt2 = jnp.split(mod[:, None, :], 6, axis=-1)
        h = rms_norm(x, g_pre_mix[l]) * (1 + sc1) + sh1
        y = token_mixer(h, positions, w_in[l], cmp_pos_k[l], cmp_k_w1[l], cmp_k_w2[l], cmp_pos_v[l],
                        cmp_v_w1[l], cmp_v_w2[l], pool_w[l], pool_scale[l], w_pool_up[l], w_nsa_up[l], w_out[l])
        x = x + gt1 * rms_norm(y, g_post_mix[l])
        h = rms_norm(x, g_pre_ffn[l]) * (1 + sc2) + sh2
        y = moe_ffn(h, w_router[l], router_bias[l], w_exp_gate[l], w_exp_up[l], w_exp_down[l],
                    w_sh_gate[l], w_sh_up[l], w_sh_down[l])
        x = x + gt2 * rms_norm(y, g_post_ffn[l])
    return x
```

```cpp
#include <hip/hip_runtime.h>
#include <cstdio>
#include <cstdint>

namespace pg8 {
#define PG8_LAS __attribute__((address_space(3)))
typedef unsigned short bf16_t;
typedef short bf16x8 __attribute__((ext_vector_type(8)));
typedef float f32x4 __attribute__((ext_vector_type(4)));
typedef float f32x2 __attribute__((ext_vector_type(2)));
typedef unsigned u32x4 __attribute__((ext_vector_type(4)));
typedef unsigned u32x2 __attribute__((ext_vector_type(2)));
constexpr int BM = 256, BK = 64, HALF = 128, HTB = HALF * BK * 2, STAGE_BYTES = 8 * HTB, NXCD = 8, WGM = 8;

__host__ __device__ __forceinline__ int lds_byte(int r, int c) { const int st = (r >> 4) * 2 + (c >> 5), rr = r & 15, cc = c & 31, ob = rr * 64 + cc * 2; return st * 1024 + (ob ^ (((ob >> 9) & 1) << 5)); }
__host__ __device__ __forceinline__ void stage_rc(int b, int& R, int& C) { const int st = b / 1024, sb = b % 1024, swz = sb ^ (((sb >> 9) & 1) << 5); R = (st >> 1) * 16 + swz / 64; C = (st & 1) * 32 + (swz % 64) / 2; }
__host__ __device__ __forceinline__ int perm32(int rho) { const int n = rho >> 4, i = rho & 15; return 8 * (i >> 2) + 4 * n + (i & 3); }

struct Unit { int pm, pn, aux; };
struct Gemm { const bf16_t* A; int ldb, K; };

__device__ __forceinline__ bool static_tile(int i, int G, int c, int nM, int nN, int& pm, int& pn) {
    const int nwg = nM * nN; const long L = (long)i * G + c; if (L >= nwg) return false;
    int wgid = (int)L; { const int q = nwg / NXCD, r = nwg % NXCD, xcd = wgid % NXCD, off = wgid / NXCD; wgid = (xcd < r ? xcd * (q + 1) : r * (q + 1) + (xcd - r) * q) + off; }
    const int nig = WGM * nN, gid = wgid / nig, fm = gid * WGM, gsz = (nM - fm) < WGM ? (nM - fm) : WGM;
    pm = fm + ((wgid % nig) % gsz); pn = (wgid % nig) / gsz; return true;
}
__device__ __forceinline__ unsigned cvt_pk_bf16(float lo, float hi) { unsigned r; asm volatile("v_cvt_pk_bf16_f32 %0, %1, %2" : "=v"(r) : "v"(lo), "v"(hi)); return r; }

template <class Epi, class Sched, bool ALIGN_EPI = true>
__device__ __forceinline__ void gemm_phase(PG8_LAS unsigned char* lds, const Gemm g, const Sched& S, const Epi& E) {
    int tid = threadIdx.x; asm volatile("" : "+v"(tid));
    const int wid = __builtin_amdgcn_readfirstlane(tid >> 6), lane = tid & 63, wr = wid >> 2, wc = wid & 3, fr = lane & 15, fq = lane >> 4;
    const int nt = g.K / BK;
    int Rst[2], Cst[2]; unsigned voffB[2];
#pragma unroll
    for (int i = 0; i < 2; ++i) { int R, C; stage_rc(tid * 16 + i * 8192, R, C); const int Rb = Epi::PERM ? ((R & ~31) + perm32(R & 31)) : R;
        Rst[i] = R; Cst[i] = C; voffB[i] = (unsigned)(Rb * g.ldb + C) * 2u; }
    const unsigned kstep = (unsigned)(BK * 2);
    const size_t hstepB = (size_t)HALF * g.ldb * 2;
    const unsigned ldsw = (unsigned)wid * 1024u;
    const int aoff = lds_byte(wr * 64 + fr, fq * 8), boff = lds_byte(wc * 32 + fr, fq * 8);
    const char* Ab = (const char*)g.A;
#define PG8_SA(b, h) (((b) * 2 + (h)) * HTB)
#define PG8_SB(b, h) ((4 + (b) * 2 + (h)) * HTB)
#define PG8_STAGEB(bufoff, gbase) do { _Pragma("unroll") for (int _i = 0; _i < 2; ++_i) \
        __builtin_amdgcn_global_load_lds((const unsigned*)((const char*)(gbase) + voffB[_i]), (PG8_LAS unsigned*)(lds + (bufoff) + ldsw + _i * 8192), 16, 0, 0); } while (0)
#define PG8_STAGEA(bufoff, vo0, vo1, kb) do { \
        __builtin_amdgcn_global_load_lds((const unsigned*)(Ab + (size_t)(vo0) + (kb)), (PG8_LAS unsigned*)(lds + (bufoff) + ldsw), 16, 0, 0); \
        __builtin_amdgcn_global_load_lds((const unsigned*)(Ab + (size_t)(vo1) + (kb)), (PG8_LAS unsigned*)(lds + (bufoff) + ldsw + 8192), 16, 0, 0); } while (0)
#define PG8_LDA(dst, b, h) do { _Pragma("unroll") for (int m = 0; m < 4; ++m) _Pragma("unroll") for (int k = 0; k < 2; ++k) dst[m][k] = *(const PG8_LAS bf16x8*)(lds + PG8_SA(b, h) + aoff + m * 2048 + k * 1024); } while (0)
#define PG8_LDB(dst, b, h) do { _Pragma("unroll") for (int n = 0; n < 2; ++n) _Pragma("unroll") for (int k = 0; k < 2; ++k) dst[n][k] = *(const PG8_LAS bf16x8*)(lds + PG8_SB(b, h) + boff + n * 2048 + k * 1024); } while (0)
#define PG8_MMA(ai, bj, At, Bt) do { __builtin_amdgcn_s_setprio(1); _Pragma("unroll") for (int m = 0; m < 4; ++m) _Pragma("unroll") for (int n = 0; n < 2; ++n) _Pragma("unroll") for (int k = 0; k < 2; ++k) \
        acc[ai][bj][m][n] = __builtin_amdgcn_mfma_f32_16x16x32_bf16(Bt[n][k], At[m][k], acc[ai][bj][m][n], 0, 0, 0); __builtin_amdgcn_s_setprio(0); } while (0)
#define PG8_WAIT_V(n) asm volatile("s_waitcnt vmcnt(" #n ")" ::: "memory")
#define PG8_WAIT_L(n) asm volatile("s_waitcnt lgkmcnt(" #n ")" ::: "memory")
#define PG8_BAR __builtin_amdgcn_s_barrier()
#define PG8_SCHED __builtin_amdgcn_sched_barrier(0)
    Unit cur, nxt; int ui = 0;
    if (!S.next(0, cur)) return;
    f32x4 acc[2][2][4][2];
#pragma unroll
    for (int a = 0; a < 2; ++a)
#pragma unroll
        for (int b = 0; b < 2; ++b)
#pragma unroll
            for (int m = 0; m < 4; ++m)
#pragma unroll
                for (int n = 0; n < 2; ++n) acc[a][b][m][n] = (f32x4){0.f, 0.f, 0.f, 0.f};
    bf16x8 At[4][2], B0[2][2], B1[2][2];
    unsigned c00, c01, c10, c11, n00, n01, n10, n11;
    c00 = S.aoff(cur, Rst[0]) + (unsigned)Cst[0] * 2u; c01 = S.aoff(cur, Rst[1]) + (unsigned)Cst[1] * 2u;
    c10 = S.aoff(cur, HALF + Rst[0]) + (unsigned)Cst[0] * 2u; c11 = S.aoff(cur, HALF + Rst[1]) + (unsigned)Cst[1] * 2u;
    const char* cB = S.bptr(cur);
    PG8_WAIT_V(0);
    PG8_STAGEB(PG8_SB(0, 0), cB); PG8_STAGEB(PG8_SB(0, 1), cB + hstepB); PG8_STAGEA(PG8_SA(0, 0), c00, c01, 0u); PG8_STAGEA(PG8_SA(0, 1), c10, c11, 0u);
    if (wr == 1) PG8_BAR;
    PG8_WAIT_V(2); PG8_BAR;
    PG8_STAGEB(PG8_SB(1, 0), cB + kstep); PG8_STAGEA(PG8_SA(1, 0), c00, c01, kstep); PG8_STAGEB(PG8_SB(1, 1), cB + hstepB + kstep);
    PG8_WAIT_V(6); PG8_BAR;
    for (;;) {
        const bool has_next = S.next(ui + 1, nxt);
        const char* nB = cB; n00 = c00; n01 = c01; n10 = c10; n11 = c11;
        if (has_next) {
            nB = S.bptr(nxt);
            n00 = S.aoff(nxt, Rst[0]) + (unsigned)Cst[0] * 2u; n01 = S.aoff(nxt, Rst[1]) + (unsigned)Cst[1] * 2u;
            n10 = S.aoff(nxt, HALF + Rst[0]) + (unsigned)Cst[0] * 2u; n11 = S.aoff(nxt, HALF + Rst[1]) + (unsigned)Cst[1] * 2u;
        }
#pragma nounroll
        for (int t = 0; t < nt; t += 2) {
            const bool last = (t == nt - 2);
            const unsigned k1 = (unsigned)(t + 1) * kstep;
            const unsigned k2 = last ? 0u : (unsigned)(t + 2) * kstep, k3 = k2 + kstep;
            const char* b2 = last ? nB : cB;
            const unsigned a00 = last ? n00 : c00, a01 = last ? n01 : c01, a10 = last ? n10 : c10, a11 = last ? n11 : c11;
            PG8_LDB(B0, 0, 0); PG8_LDB(B1, 0, 1); PG8_SCHED; PG8_LDA(At, 0, 0); PG8_STAGEA(PG8_SA(1, 1), c10, c11, k1);
            PG8_WAIT_V(8); PG8_WAIT_L(0); PG8_BAR; PG8_MMA(0, 0, At, B0); PG8_MMA(0, 1, At, B1); PG8_BAR; PG8_SCHED;
            PG8_LDA(At, 0, 1); PG8_STAGEB(PG8_SB(0, 0), b2 + k2); PG8_STAGEB(PG8_SB(0, 1), b2 + hstepB + k2); PG8_STAGEA(PG8_SA(0, 0), a00, a01, k2);
            PG8_WAIT_V(8); PG8_WAIT_L(0); PG8_BAR; PG8_MMA(1, 0, At, B0); PG8_MMA(1, 1, At, B1); PG8_BAR; PG8_SCHED;
            PG8_LDB(B0, 1, 0); PG8_LDB(B1, 1, 1); PG8_SCHED; PG8_LDA(At, 1, 0); PG8_STAGEA(PG8_SA(0, 1), a10, a11, k2);
            PG8_WAIT_V(8); PG8_WAIT_L(0); PG8_BAR; PG8_MMA(0, 0, At, B0); PG8_MMA(0, 1, At, B1); PG8_BAR; PG8_SCHED;
            PG8_LDA(At, 1, 1); PG8_STAGEB(PG8_SB(1, 0), b2 + k3); PG8_STAGEB(PG8_SB(1, 1), b2 + hstepB + k3); PG8_STAGEA(PG8_SA(1, 0), a00, a01, k3);
            PG8_WAIT_V(8); PG8_WAIT_L(0); PG8_BAR; PG8_MMA(1, 0, At, B0); PG8_MMA(1, 1, At, B1); PG8_BAR; PG8_SCHED;
        }
        if constexpr (ALIGN_EPI) { if (wr == 0) PG8_BAR; }
        E(acc, cur, wr, wc, fr, fq);
        if (!has_next) break;
#pragma unroll
        for (int a = 0; a < 2; ++a)
#pragma unroll
            for (int b = 0; b < 2; ++b)
#pragma unroll
                for (int m = 0; m < 4; ++m)
#pragma unroll
                    for (int n = 0; n < 2; ++n) acc[a][b][m][n] = (f32x4){0.f, 0.f, 0.f, 0.f};
        cur = nxt; cB = nB; c00 = n00; c01 = n01; c10 = n10; c11 = n11; ++ui;
        if constexpr (ALIGN_EPI) { if (wr == 1) PG8_BAR; }
    }
    PG8_WAIT_V(0);
    if constexpr (!ALIGN_EPI) { if (wr == 0) PG8_BAR; }
    PG8_BAR;
#undef PG8_SA
#undef PG8_SB
#undef PG8_STAGEA
#undef PG8_STAGEB
#undef PG8_LDA
#undef PG8_LDB
#undef PG8_MMA
#undef PG8_WAIT_V
#undef PG8_WAIT_L
#undef PG8_BAR
#undef PG8_SCHED
}
}
#ifndef PH_HI
#define PH_HI 14
#endif
#ifndef PH_LO
#define PH_LO 0
#endif
constexpr int T = 8192, D = 2048;
constexpr int NP = 8704;
constexpr int IN_COLS = 8624;
constexpr int C_U = 0, C_Q = 1024, C_KC = 2560, C_VC = 2944, C_KS = 3200, C_VS = 3584, C_KW = 3840, C_VW = 4224, C_GN = 4480, C_GM = 4528;
constexpr int NH = 16, NG = 4, DQK = 96, DV = 64, ROT = 24, HALFROT = 12;
constexpr int NCMP = 511, NCMPP = 512, NSLC = 128, NSEL = 16, WIN = 512;
constexpr int NE = 64, NE1 = 65, TOPK = 8, DE = 512;
constexpr int MAXTILES = 352;
constexpr float RMS_EPS = 1e-6f;
constexpr int NWAVES = 8;

constexpr size_t MiB = 1u << 20;
constexpr size_t WS_CTL = 0, CTL_ZERO_BYTES = 1 * MiB;
constexpr size_t WS_WIN = 1 * MiB;
constexpr size_t WS_WOUT = 35 * MiB;
constexpr size_t WS_WPU = 43 * MiB;
constexpr size_t WS_WNU = 47 * MiB;
constexpr size_t WS_WCK = 51 * MiB;
constexpr size_t WS_WCV = 54 * MiB;
constexpr size_t WS_WPOOL = 55 * MiB;
constexpr size_t WS_WRT = 55 * MiB + 512 * 1024;
constexpr size_t WS_W1 = 56 * MiB;
constexpr size_t WS_W2 = 316 * MiB;
constexpr size_t WS_SMALL = 446 * MiB;
constexpr size_t SM_MOD = 0;
constexpr size_t SM_BIASK = 65536;
constexpr size_t SM_BIASV = 65536 + 2048;
constexpr size_t SM_ROPE = 131072;
constexpr size_t SM_END = 131072 + 786432;
constexpr size_t WS_ACT = 448 * MiB;
constexpr size_t WS_X1 = WS_ACT;
constexpr size_t WS_H2HI = WS_ACT + 64 * MiB;
constexpr size_t WS_H2LO = WS_ACT + 96 * MiB;
constexpr size_t WS_OV = WS_ACT + 128 * MiB;
constexpr size_t WS_HID = WS_OV;
constexpr size_t WS_YB = WS_OV + 88 * MiB;
constexpr size_t WS_PROJ = WS_OV;
constexpr size_t WS_QR = WS_OV + 136 * MiB;
constexpr size_t WS_KSG = WS_OV + 160 * MiB;
constexpr size_t WS_KWG = WS_OV + 166 * MiB;
constexpr size_t WS_KCG = WS_OV + 172 * MiB;
constexpr size_t WS_VCG = WS_OV + 179 * MiB;
constexpr size_t WS_VST = WS_OV + 184 * MiB;
constexpr size_t WS_VWT = WS_OV + 188 * MiB;
constexpr size_t WS_DPOOL = WS_OV + 192 * MiB;
constexpr size_t WS_APOOL = WS_OV + 208 * MiB;
constexpr size_t WS_PARTK = WS_OV + 224 * MiB;
constexpr size_t WS_PARTV = WS_OV + 240 * MiB;
constexpr size_t WS_KCR = WS_OV + 248 * MiB;
constexpr size_t WS_VCT = WS_OV + 248 * MiB + 512 * 1024;
constexpr size_t WS_YPART = WS_OV + 249 * MiB;
constexpr size_t WS_O = WS_OV + 281 * MiB;
constexpr size_t WS_Y = WS_OV + 297 * MiB;
constexpr size_t WS_Z = WS_OV + 329 * MiB;
constexpr size_t WS_H = WS_OV + 393 * MiB;
constexpr size_t WS_TAB = WS_OV + 440 * MiB;
constexpr size_t TB_SELE = 0;
constexpr size_t TB_SELW = 262144;
constexpr size_t TB_SELR = 524288;
constexpr size_t TB_POS = 786432;
constexpr size_t TB_TOK = 1048576;
constexpr size_t TB_WROW = 1048576 + 524288;
constexpr size_t WS_END = WS_TAB + 4 * MiB;
static_assert(WS_END <= 1024 * MiB, "ws map");
static_assert(WS_YB + (size_t)MAXTILES * 256 * 2048 * 2 <= WS_TAB, "YB");
constexpr int CW_BAR = 4096;
constexpr int CW_CNT = 16384;

constexpr int RING_OFF = 0, RING_BYTES = 131072;
constexpr int LDSCTL_OFF = RING_BYTES, MISC_OFF = LDSCTL_OFF + 320;
constexpr int LDS_BYTES = 147456;
constexpr int LDS_X = MISC_OFF + 128;

#define GAS __attribute__((address_space(1)))
#define LAS __attribute__((address_space(3)))
typedef unsigned short bf16;
typedef unsigned v4u __attribute__((ext_vector_type(4)));
typedef unsigned v2u __attribute__((ext_vector_type(2)));
typedef float f32x4 __attribute__((ext_vector_type(4)));
typedef float f32x16 __attribute__((ext_vector_type(16)));
typedef short bf16x8 __attribute__((ext_vector_type(8)));
typedef short s16x4 __attribute__((ext_vector_type(4)));
typedef GAS unsigned gu32;
#define RLX_AGENT __ATOMIC_RELAXED, __HIP_MEMORY_SCOPE_AGENT
#define LDS_WAIT() asm volatile("s_waitcnt lgkmcnt(0)" ::: "memory")
#define VM_WAIT() asm volatile("s_waitcnt vmcnt(0)" ::: "memory")
__device__ __forceinline__ unsigned f2bf(float f) { unsigned u = __builtin_bit_cast(unsigned, f); return (u + 0x7fffu + ((u >> 16) & 1u)) >> 16; }
__device__ __forceinline__ unsigned pk2(float lo, float hi) { return f2bf(lo) | (f2bf(hi) << 16); }
__device__ __forceinline__ float bf2f(unsigned b) { return __builtin_bit_cast(float, b << 16); }
__device__ __forceinline__ float bflo(unsigned w) { return __builtin_bit_cast(float, w << 16); }
__device__ __forceinline__ float bfhi(unsigned w) { return __builtin_bit_cast(float, w & 0xffff0000u); }
__device__ __forceinline__ float sigmoidf_(float v) { return 1.0f / (1.0f + __expf(-v)); }

#define XB_TMO      128
#define XB_XCNT(j)  (256  + 64 * (j))
#define XB_XSUB(j)  (1280 + 64 * (j))
#define XB_XGEN(j)  (2304 + 64 * (j))
#define XB_TOP      3328
#define XB_TOPGEN   3392
#define XCD_BAR_WORDS 3456
#define XB_SPIN_CAP (1u << 18)
__device__ __forceinline__ unsigned xb_ld(unsigned* p)              { return __hip_atomic_load(p, __ATOMIC_RELAXED, __HIP_MEMORY_SCOPE_AGENT); }
__device__ __forceinline__ unsigned xb_add(unsigned* p, unsigned v) { return __hip_atomic_fetch_add(p, v, __ATOMIC_RELAXED, __HIP_MEMORY_SCOPE_AGENT); }
__device__ __forceinline__ unsigned xb_xcc_id() { return (unsigned)__builtin_amdgcn_s_getreg((3 << 11) | 20) & 0xFu; }
#define XB_SPIN(cond, bar) do { unsigned _sp = 0; while (cond) { __builtin_amdgcn_s_sleep(1); \
    if ((++_sp & 255u) == 0u) { if (xb_ld(&(bar)[XB_TMO])) break; if (_sp > XB_SPIN_CAP) { atomicAdd(&(bar)[XB_TMO], 1u); break; } } } } while (0)
struct XcdBarrier { unsigned* bar; unsigned x; volatile LAS unsigned* st; };
__device__ __forceinline__ XcdBarrier xcd_barrier_post(unsigned* bar, volatile LAS unsigned* st) {
    XcdBarrier b; b.bar = bar; b.x = xb_xcc_id(); b.st = st;
    if (threadIdx.x == 0) (void)xb_add(&bar[XB_XCNT(b.x)], 1u);
    return b;
}
__device__ __forceinline__ void xcd_barrier_complete(unsigned* bar, unsigned x, unsigned& nloc, unsigned& nx) {
    const unsigned G = gridDim.x * gridDim.y * gridDim.z;
    unsigned sum, cnt, mine, sp = 0u;
    for (;;) {
        sum = 0u; cnt = 0u; mine = 0u;
#pragma unroll
        for (unsigned j = 0; j < 16; ++j) { const unsigned c = xb_ld(&bar[XB_XCNT(j)]); sum += c; cnt += (c > 0u) ? 1u : 0u; mine = (j == x) ? c : mine; }
        if (sum == G) break;
        __builtin_amdgcn_s_sleep(1);
        if ((++sp & 255u) == 0u) { if (xb_ld(&bar[XB_TMO])) break; if (sp > XB_SPIN_CAP) { atomicAdd(&bar[XB_TMO], 1u); break; } }
    }
    nloc = mine > 0u ? mine : 1u; nx = cnt > 0u ? cnt : 1u;
}
__device__ __forceinline__ void xcd_barrier(const XcdBarrier& b) {
    asm volatile("s_waitcnt vmcnt(0)" ::: "memory");
    __syncthreads();
    if (threadIdx.x == 0) {
        unsigned* bar = b.bar;
        __builtin_amdgcn_s_waitcnt(0);
        unsigned nloc = b.st[0], nx = b.st[1];
        if (nloc == 0u) { xcd_barrier_complete(bar, b.x, nloc, nx); b.st[0] = nloc; b.st[1] = nx; }
        const unsigned old = xb_add(&bar[XB_XSUB(b.x)], 1u);
        const unsigned gen = old / nloc;
        if (old + 1u == (gen + 1u) * nloc) {
            __builtin_amdgcn_fence(__ATOMIC_RELEASE, "agent");
            asm volatile("s_waitcnt vmcnt(0)" ::: "memory");
            const unsigned og = xb_add(&bar[XB_TOP], 1u);
            const unsigned tg = og / nx;
            if (og + 1u == (tg + 1u) * nx) xb_add(&bar[XB_TOPGEN], 1u);
            else XB_SPIN(xb_ld(&bar[XB_TOPGEN]) == tg, bar);
            __builtin_amdgcn_fence(__ATOMIC_ACQUIRE, "agent");
            xb_add(&bar[XB_XGEN(b.x)], 1u);
            asm volatile("s_waitcnt vmcnt(0)" ::: "memory");
        } else {
            XB_SPIN(xb_ld(&bar[XB_XGEN(b.x)]) == gen, bar);
            __builtin_amdgcn_fence(__ATOMIC_ACQUIRE, "agent");
            asm volatile("s_waitcnt vmcnt(0)" ::: "memory");
        }
    }
    __syncthreads();
}

__device__ __forceinline__ float wave_sum(float v) {
#pragma unroll
    for (int o = 1; o < 64; o <<= 1) v += __shfl_xor(v, o);
    return v;
}
struct Frame {
    LAS unsigned char* lds;
    volatile LAS unsigned* MISC;
    gu32* ctl;
    unsigned char* ws;
    int tid, lane, wave, G, bid;
    const float *x, *c; const int* positions;
    const float *w_ada, *b_ada, *g_pre_mix, *g_post_mix, *g_pre_ffn, *g_post_ffn, *w_in;
    const float *cmp_pos_k, *cmp_k_w1, *cmp_k_w2, *cmp_pos_v, *cmp_v_w1, *cmp_v_w2, *pool_w, *pool_scale;
    const float *w_pool_up, *w_nsa_up, *w_out, *w_router, *router_bias, *w_exp_gate, *w_exp_up, *w_exp_down, *w_sh_gate, *w_sh_up, *w_sh_down;
    float* out;
};

__device__ __forceinline__ void transpose_item(const float* W, int ldw, int nvalid, bf16* WT, int ldt, int k0, int n0, int dst_row0, const float* scale, LAS float* scr, int lane) {
    const int nn = n0 + (lane & 31); const bool ok = nn < nvalid;
    const float sc = (scale && ok) ? scale[nn] : 1.0f;
#pragma unroll 8
    for (int i = 0; i < 32; ++i) { const int kk = 2 * i + (lane >> 5); scr[kk * 33 + (lane & 31)] = ok ? W[(size_t)(k0 + kk) * ldw + nn] * sc : 0.f; }
    LDS_WAIT(); asm volatile("" ::: "memory");
    const int c = lane & 7;
#pragma unroll
    for (int j = 0; j < 4; ++j) { const int n = (lane >> 3) + 8 * j; const LAS float* s = scr + (8 * c) * 33 + n;
        v4u o; o.x = pk2(s[0 * 33], s[1 * 33]); o.y = pk2(s[2 * 33], s[3 * 33]); o.z = pk2(s[4 * 33], s[5 * 33]); o.w = pk2(s[6 * 33], s[7 * 33]);
        *(GAS v4u*)(WT + (size_t)(dst_row0 + n) * ldt + k0 + 8 * c) = o; }
    LDS_WAIT(); asm volatile("" ::: "memory");
}
__device__ __forceinline__ void tr_job(const float* W, int K, int N, int nvalid, bf16* WT, int it, LAS float* scr, int lane) {
    const int nblk = N / 32, kb = it / nblk, nb = it % nblk;
    transpose_item(W, nvalid, nvalid, WT, K, 64 * kb, 32 * nb, 32 * nb, nullptr, scr, lane);
}

template <bool SILU>
__device__ __forceinline__ void gemv64(Frame& F, const float* vec, const float* W, int ldw, int K, int col0, const float* addend, float* out) {
    LAS float* red = (LAS float*)(F.lds + RING_OFF);
    const int rsub = F.lane >> 4, c4 = F.lane & 15;
    const int kper = K / NWAVES, kbeg = F.wave * kper;
    f32x4 acc = (f32x4){0.f, 0.f, 0.f, 0.f};
#pragma unroll 8
    for (int k = kbeg + rsub; k < kbeg + kper; k += 4) {
        float v = vec[k]; if (SILU) v = v / (1.0f + __expf(-v));
        const f32x4 w = *(const GAS f32x4*)(W + (size_t)k * ldw + col0 + 4 * c4);
        acc += w * v;
    }
#pragma unroll
    for (int j = 0; j < 4; ++j) { acc[j] += __shfl_xor(acc[j], 16); acc[j] += __shfl_xor(acc[j], 32); }
    __syncthreads();
    if (rsub == 0) { red[F.wave * 64 + 4 * c4 + 0] = acc[0]; red[F.wave * 64 + 4 * c4 + 1] = acc[1]; red[F.wave * 64 + 4 * c4 + 2] = acc[2]; red[F.wave * 64 + 4 * c4 + 3] = acc[3]; }
    __syncthreads();
    if (F.tid < 64) { float s = addend ? addend[col0 + F.tid] : 0.f;
#pragma unroll
        for (int w = 0; w < NWAVES; ++w) s += red[w * 64 + F.tid];
        out[col0 + F.tid] = s; }
    __syncthreads();
}

__device__ __forceinline__ void p0_prologue(Frame& F) {
    unsigned char* ws = F.ws;
    float* small = (float*)(ws + WS_SMALL);
    if (F.bid < 192) gemv64<true>(F, F.c, F.w_ada, 6 * D, D, 64 * F.bid, F.b_ada, small + SM_MOD / 4);
    else if (F.bid < 198) gemv64<false>(F, F.cmp_pos_k, F.cmp_k_w1, 384, 3072, 64 * (F.bid - 192), nullptr, small + SM_BIASK / 4);
    else if (F.bid < 202) gemv64<false>(F, F.cmp_pos_v, F.cmp_v_w1, 256, 2048, 64 * (F.bid - 198), nullptr, small + SM_BIASV / 4);
    {
        const float inv[12] = {1.000000000e+00f, 3.350316475e-01f, 1.122462048e-01f, 3.760603093e-02f, 1.259921050e-02f, 4.221134251e-03f, 1.414213562e-03f, 4.738062997e-04f, 1.587401052e-04f, 5.318295897e-05f, 1.781797436e-05f, 5.969585306e-06f};
        float* rope = small + SM_ROPE / 4;
        const int gt = F.bid * 512 + F.tid, NT = F.G * 512;
        for (int idx = gt; idx < T * 12; idx += NT) {
            const int t = idx / 12, i = idx % 12;
            float iv = inv[0];
#pragma unroll
            for (int q = 1; q < 12; ++q) iv = (i == q) ? inv[q] : iv;
            const float ang = (float)F.positions[t] * iv;
            const float kf = rintf(ang * 0.15915494309189535f);
            float r = fmaf(-kf, 6.2831855f, ang); r = fmaf(-kf, -1.7484555e-07f, r);
            rope[t * 24 + i] = __cosf(r); rope[t * 24 + 12 + i] = __sinf(r);
        }
        bf16* wr_hi = (bf16*)(ws + WS_WRT); bf16* wr_lo = wr_hi + 64 * 2048;
        for (int idx = gt; idx < 64 * 2048; idx += NT) {
            const int e = idx & 63, d = idx >> 6;
            const float v = F.w_router[idx];
            const unsigned h = f2bf(v); const float lo = v - bf2f(h);
            wr_hi[e * 2048 + d] = (bf16)h; wr_lo[e * 2048 + d] = (bf16)f2bf(lo);
        }
    }
    LAS float* scr = (LAS float*)(F.lds + RING_OFF + 4096 + F.wave * 8704);
    const int gw = F.bid * NWAVES + F.wave, NGW = F.G * NWAVES;
    constexpr int I_IN = 32 * 272, I_POOL = 4 * 4 * 8, I_CK = 48 * 16, I_CV = 32 * 8, I_PU = 16 * 64, I_NU = 16 * 64, I_OUT = 32 * 64;
    constexpr int I_E1 = 32 * 16, I_E2 = 8 * 64;
    constexpr int I_G = NE1 * I_E1, I_U = NE1 * I_E1, I_D = NE1 * I_E2;
    constexpr int NITEMS = I_IN + I_POOL + I_CK + I_CV + I_PU + I_NU + I_OUT + I_G + I_U + I_D;
    for (int it = gw; it < NITEMS; it += NGW) {
        int r = it;
        if (r < I_IN) { tr_job(F.w_in, 2048, NP, IN_COLS, (bf16*)(ws + WS_WIN), r, scr, F.lane); continue; } r -= I_IN;
        if (r < I_POOL) { const int g = r / 32, q = r % 32, kb = q / 8, nb = q % 8;
            transpose_item(F.pool_w + (size_t)g * 65536, 256, 256, (bf16*)(ws + WS_WPOOL) + (size_t)g * 65536, 256, 64 * kb, 32 * nb, 32 * nb, F.pool_scale + g * 256, scr, F.lane); continue; } r -= I_POOL;
        if (r < I_CK) { tr_job(F.cmp_k_w1, 3072, 512, 384, (bf16*)(ws + WS_WCK), r, scr, F.lane); continue; } r -= I_CK;
        if (r < I_CV) { tr_job(F.cmp_v_w1, 2048, 256, 256, (bf16*)(ws + WS_WCV), r, scr, F.lane); continue; } r -= I_CV;
        if (r < I_PU) { tr_job(F.w_pool_up, 1024, 2048, 2048, (bf16*)(ws + WS_WPU), r, scr, F.lane); continue; } r -= I_PU;
        if (r < I_NU) { tr_job(F.w_nsa_up, 1024, 2048, 2048, (bf16*)(ws + WS_WNU), r, scr, F.lane); continue; } r -= I_NU;
        if (r < I_OUT) { tr_job(F.w_out, 2048, 2048, 2048, (bf16*)(ws + WS_WOUT), r, scr, F.lane); continue; } r -= I_OUT;
        if (r < I_G + I_U) {
            const int s = r >= I_G ? 1 : 0; if (s) r -= I_G;
            const int e = r / I_E1, q = r % I_E1, kb = q / 16, nb = q % 16, n0 = 32 * nb;
            const float* src = (e < NE) ? ((s ? F.w_exp_up : F.w_exp_gate) + (size_t)e * 2048 * 512) : (s ? F.w_sh_up : F.w_sh_gate);
            transpose_item(src, 512, 512, (bf16*)(ws + WS_W1) + (size_t)e * 1024 * 2048, 2048, 64 * kb, n0, 256 * (n0 >> 7) + 128 * s + (n0 & 127), nullptr, scr, F.lane); continue; }
        r -= I_G + I_U;
        { const int e = r / I_E2, q = r % I_E2, kb = q / 64, nb = q % 64;
          const float* src = (e < NE) ? (F.w_exp_down + (size_t)e * 512 * 2048) : F.w_sh_down;
          transpose_item(src, 2048, 2048, (bf16*)(ws + WS_W2) + (size_t)e * 2048 * 512, 512, 64 * kb, 32 * nb, 32 * nb, nullptr, scr, F.lane); }
    }
}
__device__ __forceinline__ void p1_norm(Frame& F) {
    const float* mod = (const float*)(F.ws + WS_SMALL + SM_MOD);
    bf16* H = (bf16*)(F.ws + WS_H);
    const int gw = F.bid * NWAVES + F.wave, NGW = F.G * NWAVES;
    for (int row = gw; row < T; row += NGW) {
        const GAS f32x4* xr = (const GAS f32x4*)(F.x + (size_t)row * D) + F.lane;
        f32x4 v[8]; float ss = 0.f;
#pragma unroll
        for (int j = 0; j < 8; ++j) { v[j] = xr[64 * j]; ss += (v[j].x * v[j].x + v[j].y * v[j].y) + (v[j].z * v[j].z + v[j].w * v[j].w); }
        const float rstd = 1.0f / sqrtf(wave_sum(ss) * (1.0f / D) + RMS_EPS);
        GAS v2u* o8 = (GAS v2u*)(H + (size_t)row * D) + F.lane;
#pragma unroll
        for (int j = 0; j < 8; ++j) {
            const int col = 4 * (F.lane + 64 * j);
            const f32x4 g = *(const GAS f32x4*)(F.g_pre_mix + col), sh = *(const GAS f32x4*)(mod + col), sc = *(const GAS f32x4*)(mod + D + col);
            const f32x4 h = (v[j] * rstd) * g * (sc + 1.0f) + sh;
            v2u o; o.x = pk2(h.x, h.y); o.y = pk2(h.z, h.w); o8[64 * j] = o;
        }
    }
}

__device__ __forceinline__ void unpack8(const v4u w, float (&f)[8]) { f[0] = bflo(w.x); f[1] = bfhi(w.x); f[2] = bflo(w.y); f[3] = bfhi(w.y); f[4] = bflo(w.z); f[5] = bfhi(w.z); f[6] = bflo(w.w); f[7] = bfhi(w.w); }
__device__ __forceinline__ v4u pack8(const float (&f)[8]) { v4u o; o.x = pk2(f[0], f[1]); o.y = pk2(f[2], f[3]); o.z = pk2(f[4], f[5]); o.w = pk2(f[6], f[7]); return o; }

__device__ __forceinline__ void rope24(const bf16* src, bf16* dst, const float* cs, float scale) {
    float v[24];
    { float a[8]; unpack8(*(const GAS v4u*)(src), a);
#pragma unroll
      for (int i = 0; i < 8; ++i) v[i] = a[i];
      unpack8(*(const GAS v4u*)(src + 8), a);
#pragma unroll
      for (int i = 0; i < 8; ++i) v[8 + i] = a[i];
      unpack8(*(const GAS v4u*)(src + 16), a);
#pragma unroll
      for (int i = 0; i < 8; ++i) v[16 + i] = a[i]; }
    float o[24];
#pragma unroll
    for (int i = 0; i < 12; ++i) { const float c = cs[i], s = cs[12 + i]; o[i] = (v[i] * c - v[12 + i] * s) * scale; o[12 + i] = (v[12 + i] * c + v[i] * s) * scale; }
    float a[8];
#pragma unroll
    for (int i = 0; i < 8; ++i) a[i] = o[i];
    *(GAS v4u*)(dst) = pack8(a);
#pragma unroll
    for (int i = 0; i < 8; ++i) a[i] = o[8 + i];
    *(GAS v4u*)(dst + 8) = pack8(a);
#pragma unroll
    for (int i = 0; i < 8; ++i) a[i] = o[16 + i];
    *(GAS v4u*)(dst + 16) = pack8(a);
}
template <bool ROPE>
__device__ __forceinline__ void seg96(const bf16* src, int nheads, bf16* dbase, size_t hstride, const float* cs, float scale, int lane) {
    const int nch = nheads * 12;
    for (int ci = lane; ci < nch; ci += 64) {
        const int head = ci / 12, kk = ci % 12;
        if (ROPE && kk < 3) continue;
        float a[8]; unpack8(*(const GAS v4u*)(src + ci * 8), a);
#pragma unroll
        for (int i = 0; i < 8; ++i) a[i] *= scale;
        *(GAS v4u*)(dbase + (size_t)head * hstride + kk * 8) = pack8(a);
    }
    if (ROPE && lane < nheads) rope24(src + lane * 96, dbase + (size_t)lane * hstride, cs, scale);
}

__device__ __forceinline__ void p3_relayout(Frame& F) {
    unsigned char* ws = F.ws;
    const bf16* PROJ = (const bf16*)(ws + WS_PROJ);
    const float* rope = (const float*)(ws + WS_SMALL + SM_ROPE);
    bf16* QR = (bf16*)(ws + WS_QR); bf16* KSG = (bf16*)(ws + WS_KSG); bf16* KWG = (bf16*)(ws + WS_KWG); bf16* KCG = (bf16*)(ws + WS_KCG); bf16* VCG = (bf16*)(ws + WS_VCG);
    bf16* VST = (bf16*)(ws + WS_VST); bf16* VWT = (bf16*)(ws + WS_VWT); bf16* DPOOL = (bf16*)(ws + WS_DPOOL);
    const int gw = F.bid * NWAVES + F.wave, NGW = F.G * NWAVES, lane = F.lane;
    for (int t = gw; t < T; t += NGW) {
        const bf16* pr = PROJ + (size_t)t * NP;
        const float* cs = rope + t * 24;
#pragma unroll
        for (int j = 0; j < 2; ++j) {
            const int ci = lane + 64 * j, g = ci >> 5, win = 2 << g;
            const int cnt = (t + 1 < win) ? (t + 1) : win;
            float s[8], u[8];
#pragma unroll
            for (int i = 0; i < 8; ++i) s[i] = 0.f;
            for (int r = 0; r < cnt; ++r) { float a[8]; unpack8(*(const GAS v4u*)(pr - (size_t)r * NP + C_U + ci * 8), a);
                if (r == 0) {
#pragma unroll
                    for (int i = 0; i < 8; ++i) u[i] = a[i]; }
#pragma unroll
                for (int i = 0; i < 8; ++i) s[i] += a[i]; }
            const float ic = 1.0f / (float)cnt;
#pragma unroll
            for (int i = 0; i < 8; ++i) s[i] = s[i] * ic - u[i];
            *(GAS v4u*)(DPOOL + (size_t)t * 1024 + ci * 8) = pack8(s);
        }
        seg96<true>(pr + C_Q, NH, QR + (size_t)t * (NH * DQK), DQK, cs, 0.10206207261596575f, lane);
        seg96<true>(pr + C_KS, NG, KSG + (size_t)t * DQK, (size_t)T * DQK, cs, 1.0f, lane);
        seg96<true>(pr + C_KW, NG, KWG + (size_t)t * DQK, (size_t)T * DQK, cs, 1.0f, lane);
        seg96<false>(pr + C_KC, NG, KCG + (size_t)t * DQK, (size_t)T * DQK, cs, 1.0f, lane);
        if (lane < 32) { const int g = lane >> 3, kk = lane & 7;
            *(GAS v4u*)(VCG + ((size_t)g * T + t) * DV + kk * 8) = *(const GAS v4u*)(pr + C_VC + lane * 8); }
    }
    LAS bf16* tl = (LAS bf16*)(F.lds + RING_OFF + F.wave * 9216);
    for (int it = gw; it < 2 * NG * (T / 64); it += NGW) {
        const int tens = it / (NG * (T / 64)), rem = it % (NG * (T / 64)), g = rem / (T / 64), tt = rem % (T / 64);
        const bf16* src = PROJ + (size_t)(tt * 64 + lane) * NP + (tens ? C_VW : C_VS) + g * DV;
        bf16* dst = (tens ? VWT : VST) + ((size_t)g * DV) * T + tt * 64;
#pragma unroll
        for (int c = 0; c < 8; ++c) { const v4u w = *(const GAS v4u*)(src + c * 8);
            const unsigned ww[4] = {w.x, w.y, w.z, w.w};
#pragma unroll
            for (int q = 0; q < 4; ++q) { tl[(c * 8 + 2 * q) * 72 + lane] = (bf16)(ww[q] & 0xffffu); tl[(c * 8 + 2 * q + 1) * 72 + lane] = (bf16)(ww[q] >> 16); } }
        LDS_WAIT(); asm volatile("" ::: "memory");
#pragma unroll
        for (int c = 0; c < 8; ++c) { const v4u w = *(const LAS v4u*)(tl + lane * 72 + c * 8); *(GAS v4u*)(dst + (size_t)lane * T + c * 8) = w; }
        LDS_WAIT(); asm volatile("" ::: "memory");
    }
}
struct SchedPlain {
    int nM, nN, G, c; const char* Bt; unsigned lda2; size_t ldb2;
    __device__ __forceinline__ bool next(int i, pg8::Unit& u) const { u.aux = 0; return pg8::static_tile(i, G, c, nM, nN, u.pm, u.pn); }
    __device__ __forceinline__ unsigned aoff(const pg8::Unit& u, int r) const { return (unsigned)(u.pm * 256 + r) * lda2; }
    __device__ __forceinline__ const char* bptr(const pg8::Unit& u) const { return Bt + (size_t)u.pn * 256 * ldb2; }
};
struct SchedPool {
    int G, c; const char* Bt;
    __device__ __forceinline__ bool next(int i, pg8::Unit& u) const { const int L = i * G + c; if (L >= 128) return false; u.pm = L >> 2; u.pn = 0; u.aux = L & 3; return true; }
    __device__ __forceinline__ unsigned aoff(const pg8::Unit& u, int r) const { return (unsigned)(u.pm * 256 + r) * 2048u + (unsigned)u.aux * 512u; }
    __device__ __forceinline__ const char* bptr(const pg8::Unit& u) const { return Bt + (size_t)u.aux * 65536 * 2; }
};
struct SchedSplitK {
    int nN, G, c; const char* Bt; unsigned lda2; size_t ldb2; int kslice;
    __device__ __forceinline__ bool next(int i, pg8::Unit& u) const { const int L = i * G + c; if (L < 0 || L >= 8 * nN * 4) return false; u.aux = L & 3; const int q = L >> 2; u.pn = q % nN; u.pm = q / nN; return true; }
    __device__ __forceinline__ unsigned aoff(const pg8::Unit& u, int r) const { return (unsigned)(u.pm * 256 + r) * lda2 + (unsigned)(u.aux * kslice) * 2u; }
    __device__ __forceinline__ const char* bptr(const pg8::Unit& u) const { return Bt + (size_t)u.pn * 256 * ldb2 + (size_t)u.aux * kslice * 2; }
};
struct SchedMoe1 {
    int G, c, ntiles; const LAS int* tile_e; const int* tok; const char* W1;
    __device__ __forceinline__ bool next(int i, pg8::Unit& u) const { const int L = i * G + c; if (L >= ntiles * 4) return false; u.pm = L >> 2; u.pn = L & 3; u.aux = tile_e[u.pm]; return true; }
    __device__ __forceinline__ unsigned aoff(const pg8::Unit& u, int r) const { return (unsigned)tok[u.pm * 256 + r] * 4096u; }
    __device__ __forceinline__ const char* bptr(const pg8::Unit& u) const { return W1 + ((size_t)u.aux * 1024 + (size_t)u.pn * 256) * 4096; }
};
struct SchedMoe2 {
    int G, c, ntiles; const LAS int* tile_e; const char* W2;
    __device__ __forceinline__ bool next(int i, pg8::Unit& u) const { const int L = i * G + c; if (L >= ntiles * 8) return false; u.pm = L >> 3; u.pn = L & 7; u.aux = tile_e[u.pm]; return true; }
    __device__ __forceinline__ unsigned aoff(const pg8::Unit& u, int r) const { return (unsigned)(u.pm * 256 + r) * 1024u; }
    __device__ __forceinline__ const char* bptr(const pg8::Unit& u) const { return W2 + ((size_t)u.aux * 2048 + (size_t)u.pn * 256) * 1024; }
};

using pg8::f32x4; using pg8::u32x4;
#define EPI_ARGS const f32x4 (&acc)[2][2][4][2], const pg8::Unit& u, int wr, int wc, int fr, int fq
struct EpiBf16 {
    static constexpr bool PERM = true;
    bf16* O; int ldc; int cbase; int caux;
    __device__ __forceinline__ void operator()(EPI_ARGS) const {
        const int row0 = u.pm * 256 + wr * 64 + fr, col0 = cbase + caux * u.aux + u.pn * 256 + wc * 32 + 8 * fq;
#pragma unroll
        for (int ai = 0; ai < 2; ++ai)
#pragma unroll
            for (int m = 0; m < 4; ++m) { bf16* rowp = O + (size_t)(row0 + ai * 128 + m * 16) * ldc + col0;
#pragma unroll
                for (int bj = 0; bj < 2; ++bj) { const f32x4 v0 = acc[ai][bj][m][0], v1 = acc[ai][bj][m][1];
                    u32x4 w; w.x = pg8::cvt_pk_bf16(v0[0], v0[1]); w.y = pg8::cvt_pk_bf16(v0[2], v0[3]); w.z = pg8::cvt_pk_bf16(v1[0], v1[1]); w.w = pg8::cvt_pk_bf16(v1[2], v1[3]);
                    *(u32x4*)(rowp + bj * 128) = w; } }
    }
};
struct EpiF32 {
    static constexpr bool PERM = false;
    float* C; int ldc; size_t astride;
    __device__ __forceinline__ void operator()(EPI_ARGS) const {
        const int row0 = u.pm * 256 + wr * 64 + fr, col0 = u.pn * 256 + wc * 32 + 4 * fq;
        float* base = C + (size_t)u.aux * astride;
#pragma unroll
        for (int ai = 0; ai < 2; ++ai)
#pragma unroll
            for (int m = 0; m < 4; ++m) { float* rowp = base + (size_t)(row0 + ai * 128 + m * 16) * ldc + col0;
#pragma unroll
                for (int bj = 0; bj < 2; ++bj)
#pragma unroll
                    for (int n = 0; n < 2; ++n) *(f32x4*)(rowp + bj * 128 + n * 16) = acc[ai][bj][m][n]; }
    }
};
__device__ __forceinline__ void sig8(const u32x4 w, float (&s)[8]) {
    s[0] = sigmoidf_(bflo(w.x)); s[1] = sigmoidf_(bfhi(w.x)); s[2] = sigmoidf_(bflo(w.y)); s[3] = sigmoidf_(bfhi(w.y));
    s[4] = sigmoidf_(bflo(w.z)); s[5] = sigmoidf_(bfhi(w.z)); s[6] = sigmoidf_(bflo(w.w)); s[7] = sigmoidf_(bfhi(w.w));
}
template <bool ADD>
struct EpiGate {
    static constexpr bool PERM = true;
    bf16* O; const bf16* prev; const bf16* GM; int gcol;
    __device__ __forceinline__ void operator()(EPI_ARGS) const {
        const int row0 = u.pm * 256 + wr * 64 + fr, col0 = u.pn * 256 + wc * 32 + 8 * fq;
#pragma unroll
        for (int ai = 0; ai < 2; ++ai)
#pragma unroll
            for (int m = 0; m < 4; ++m) { const size_t row = (size_t)(row0 + ai * 128 + m * 16);
#pragma unroll
                for (int bj = 0; bj < 2; ++bj) { const int col = col0 + bj * 128;
                    float s[8]; sig8(*(const u32x4*)(GM + row * NP + gcol + col), s);
                    const f32x4 v0 = acc[ai][bj][m][0], v1 = acc[ai][bj][m][1];
                    float r[8] = {v0[0] * s[0], v0[1] * s[1], v0[2] * s[2], v0[3] * s[3], v1[0] * s[4], v1[1] * s[5], v1[2] * s[6], v1[3] * s[7]};
                    if (ADD) { const u32x4 p = *(const u32x4*)(prev + row * 2048 + col);
                        r[0] += bflo(p.x); r[1] += bfhi(p.x); r[2] += bflo(p.y); r[3] += bfhi(p.y); r[4] += bflo(p.z); r[5] += bfhi(p.z); r[6] += bflo(p.w); r[7] += bfhi(p.w); }
                    u32x4 w; w.x = pg8::cvt_pk_bf16(r[0], r[1]); w.y = pg8::cvt_pk_bf16(r[2], r[3]); w.z = pg8::cvt_pk_bf16(r[4], r[5]); w.w = pg8::cvt_pk_bf16(r[6], r[7]);
                    *(u32x4*)(O + row * 2048 + col) = w; } }
    }
};
struct EpiMoe1 {
    static constexpr bool PERM = true;
    bf16* HID;
    __device__ __forceinline__ void operator()(EPI_ARGS) const {
        const int row0 = u.pm * 256 + wr * 64 + fr, col0 = u.pn * 128 + wc * 32 + 8 * fq;
#pragma unroll
        for (int ai = 0; ai < 2; ++ai)
#pragma unroll
            for (int m = 0; m < 4; ++m) { const size_t row = (size_t)(row0 + ai * 128 + m * 16);
                float r[8];
#pragma unroll
                for (int n = 0; n < 2; ++n)
#pragma unroll
                    for (int j = 0; j < 4; ++j) { const float gt = acc[ai][0][m][n][j], up = acc[ai][1][m][n][j]; r[4 * n + j] = gt / (1.0f + __expf(-gt)) * up; }
                u32x4 w; w.x = pg8::cvt_pk_bf16(r[0], r[1]); w.y = pg8::cvt_pk_bf16(r[2], r[3]); w.z = pg8::cvt_pk_bf16(r[4], r[5]); w.w = pg8::cvt_pk_bf16(r[6], r[7]);
                *(u32x4*)(HID + row * 512 + col0) = w; }
    }
};
struct EpiMoe2 {
    static constexpr bool PERM = true;
    bf16* YB; const float* wrow;
    __device__ __forceinline__ void operator()(EPI_ARGS) const {
        const int row0 = u.pm * 256 + wr * 64 + fr, col0 = u.pn * 256 + wc * 32 + 8 * fq;
#pragma unroll
        for (int ai = 0; ai < 2; ++ai)
#pragma unroll
            for (int m = 0; m < 4; ++m) { const size_t row = (size_t)(row0 + ai * 128 + m * 16); const float ws_ = wrow[row];
#pragma unroll
                for (int bj = 0; bj < 2; ++bj) { const f32x4 v0 = acc[ai][bj][m][0] * ws_, v1 = acc[ai][bj][m][1] * ws_;
                    u32x4 w; w.x = pg8::cvt_pk_bf16(v0[0], v0[1]); w.y = pg8::cvt_pk_bf16(v0[2], v0[3]); w.z = pg8::cvt_pk_bf16(v1[0], v1[1]); w.w = pg8::cvt_pk_bf16(v1[2], v1[3]);
                    *(u32x4*)(YB + row * 2048 + col0 + bj * 128) = w; } }
    }
};
__device__ __forceinline__ void p5_cmp2(Frame& F) {
    unsigned char* ws = F.ws;
    const float* PARTK = (const float*)(ws + WS_PARTK); const float* PARTV = (const float*)(ws + WS_PARTV);
    const float* biask = (const float*)(ws + WS_SMALL + SM_BIASK); const float* biasv = (const float*)(ws + WS_SMALL + SM_BIASV);
    const float* rope = (const float*)(ws + WS_SMALL + SM_ROPE);
    bf16* KCR = (bf16*)(ws + WS_KCR); bf16* VCT = (bf16*)(ws + WS_VCT);
    LAS float* hid = (LAS float*)(F.lds + RING_OFF + F.wave * 2048);
    LAS float* ov = hid + 384;
    const int gw = F.bid * NWAVES + F.wave, NGW = F.G * NWAVES, lane = F.lane;
    for (int row = gw; row < NG * NCMPP; row += NGW) {
        const int g = row >> 9, n = row & 511;
        if (n == NCMP) {
            for (int j = lane; j < DQK; j += 64) KCR[(size_t)row * DQK + j] = 0;
            VCT[((size_t)g * DV + lane) * NCMPP + n] = 0;
            continue;
        }
        for (int c = lane; c < 384; c += 64) { float s = biask[c];
#pragma unroll
            for (int ks = 0; ks < 4; ++ks) s += PARTK[((size_t)ks * 2048 + row) * 512 + c];
            hid[c] = s / (1.0f + __expf(-s)); }
        LDS_WAIT(); asm volatile("" ::: "memory");
        { float a0 = 0.f, a1 = 0.f; const int j1 = (lane < 32) ? 64 + lane : 0;
#pragma unroll 8
          for (int c = 0; c < 384; ++c) { const float hv = hid[c]; a0 += hv * F.cmp_k_w2[c * DQK + lane]; a1 += hv * F.cmp_k_w2[c * DQK + j1]; }
          ov[lane] = a0; if (lane < 32) ov[64 + lane] = a1; }
        LDS_WAIT(); asm volatile("" ::: "memory");
        { const float* cs = rope + (16 * n + 31) * 24;
          for (int j = lane; j < DQK; j += 64) { float v = ov[j];
              if (j < HALFROT) v = ov[j] * cs[j] - ov[j + HALFROT] * cs[HALFROT + j];
              else if (j < ROT) v = ov[j] * cs[j - HALFROT] + ov[j - HALFROT] * cs[j];
              KCR[(size_t)row * DQK + j] = (bf16)f2bf(v); } }
        LDS_WAIT(); asm volatile("" ::: "memory");
        for (int c = lane; c < 256; c += 64) { float s = biasv[c];
#pragma unroll
            for (int ks = 0; ks < 4; ++ks) s += PARTV[((size_t)ks * 2048 + row) * 256 + c];
            hid[c] = s / (1.0f + __expf(-s)); }
        LDS_WAIT(); asm volatile("" ::: "memory");
        { float a0 = 0.f;
#pragma unroll 8
          for (int c = 0; c < 256; ++c) a0 += hid[c] * F.cmp_v_w2[c * DV + lane];
          VCT[((size_t)g * DV + lane) * NCMPP + n] = (bf16)f2bf(a0); }
        LDS_WAIT(); asm volatile("" ::: "memory");
    }
}

namespace nsa {
typedef __bf16 bf16x2_t __attribute__((ext_vector_type(2)));
typedef float f32x2_t __attribute__((ext_vector_type(2)));
constexpr int KT_PITCH = 208, KT_BYTES = 64 * KT_PITCH;
constexpr int VT_PITCH = 144, VT_BYTES = 64 * VT_PITCH;
constexpr int L_KT = 0, L_VT = 2 * KT_BYTES, L_IMP = L_VT + 2 * VT_BYTES, IMP_PITCH = 129, L_SEL = L_IMP + 64 * IMP_PITCH * 4, L_END = L_SEL + 64 * 8 * 2;
static_assert(L_END <= RING_BYTES, "attention LDS");
constexpr float NEGBIG = -1e30f;
__device__ __forceinline__ unsigned cvtpk(float lo, float hi) { f32x2_t v = {lo, hi}; bf16x2_t b = __builtin_convertvector(v, bf16x2_t); return __builtin_bit_cast(unsigned, b); }
__device__ __forceinline__ int crow(int i, int h) { return (i & 3) + 8 * (i >> 2) + 4 * h; }
#define MFMA32(a, b, c) __builtin_amdgcn_mfma_f32_32x32x16_bf16((a), (b), (c), 0, 0, 0)

struct TileRegs { v4u k0, k1, v; };
template <bool WITH_V>
__device__ __forceinline__ void tile_load(TileRegs& R, const bf16* ksrc, const bf16* vsrc, int vlen, int tid) {
    R.k0 = *(const GAS v4u*)(ksrc + tid * 8);
    if (tid < 256) R.k1 = *(const GAS v4u*)(ksrc + (512 + tid) * 8);
    if (WITH_V) R.v = *(const GAS v4u*)(vsrc + (unsigned)((tid >> 3) * vlen + (tid & 7) * 8));
}
template <bool WITH_V>
__device__ __forceinline__ void tile_store(const TileRegs& R, LAS unsigned char* kt, LAS unsigned char* vt, int tid) {
    { const int q = tid; *(LAS v4u*)(kt + (q / 12) * KT_PITCH + (q % 12) * 16) = R.k0; }
    if (tid < 256) { const int q = 512 + tid; *(LAS v4u*)(kt + (q / 12) * KT_PITCH + (q % 12) * 16) = R.k1; }
    if (WITH_V) *(LAS v4u*)(vt + (tid >> 3) * VT_PITCH + (tid & 7) * 16) = R.v;
}

template <int MODE>
__device__ __forceinline__ void branch(LAS unsigned char* lds, const bf16* kbase, const bf16* vbase, int vlen, int tile0, int ntiles,
                                       const bf16x8 (&qf)[6], int t, int tok_l, int head, int r, int h, int tid,
                                       float& m, float& l, float linv, f32x16 (&O)[2]) {
    constexpr bool WITH_V = (MODE != 0);
    LAS unsigned char* KT = lds + L_KT; LAS unsigned char* VT = lds + L_VT;
    LAS float* IMP = (LAS float*)(lds + L_IMP);
    const LAS unsigned short* SEL = (const LAS unsigned short*)(lds + L_SEL);
    TileRegs R;
    tile_load<WITH_V>(R, kbase + (size_t)tile0 * 64 * DQK, vbase + tile0 * 64, vlen, tid);
    tile_store<WITH_V>(R, KT, VT, tid);
    __syncthreads();
    for (int it = 0; it < ntiles; ++it) {
        const int buf = it & 1, key0 = (tile0 + it) * 64;
        const bool more = it + 1 < ntiles;
        if (more) tile_load<WITH_V>(R, kbase + (size_t)(tile0 + it + 1) * 64 * DQK, vbase + (tile0 + it + 1) * 64, vlen, tid);
        const LAS unsigned char* kt = KT + buf * KT_BYTES; const LAS unsigned char* vt = VT + buf * VT_BYTES;
        unsigned selbit = 1u;
        if (MODE == 2) { const int j = tile0 + it; selbit = ((unsigned)SEL[tok_l * 8 + (j >> 4)] >> (j & 15)) & 1u; }
#pragma nounroll
        for (int sub = 0; sub < 2; ++sub) {
            f32x16 x;
#pragma unroll
            for (int i = 0; i < 16; ++i) x[i] = 0.f;
#pragma unroll
            for (int s = 0; s < 6; ++s) { const bf16x8 kf = *(const LAS bf16x8*)(kt + (32 * sub + r) * KT_PITCH + 32 * s + 16 * h); x = MFMA32(kf, qf[s], x); }
            bool ok[16];
#pragma unroll
            for (int i = 0; i < 16; ++i) { const int kp = key0 + 32 * sub + crow(i, h);
                if (MODE <= 1) ok[i] = (16 * kp + 31 <= t);
                else if (MODE == 2) ok[i] = (selbit != 0u) && (kp <= t);
                else ok[i] = (kp <= t) && (kp > t - WIN); }
            if (MODE == 0 || MODE >= 2) {
                float mloc = NEGBIG;
#pragma unroll
                for (int i = 0; i < 16; ++i) mloc = ok[i] ? fmaxf(mloc, x[i]) : mloc;
                mloc = fmaxf(mloc, __shfl_xor(mloc, 32));
                const float mnew = fmaxf(m, mloc);
                const float alpha = __expf(m - mnew);
                m = mnew;
                float ps = 0.f;
#pragma unroll
                for (int i = 0; i < 16; ++i) { const float p = ok[i] ? __expf(x[i] - mnew) : 0.f; x[i] = p; ps += p; }
                l = l * alpha + ps;
                if (MODE >= 2) {
#pragma unroll
                    for (int i = 0; i < 16; ++i) { O[0][i] *= alpha; O[1][i] *= alpha; }
                }
            } else {
#pragma unroll
                for (int i = 0; i < 16; ++i) x[i] = ok[i] ? __expf(x[i] - m) * linv : 0.f;
#pragma unroll
                for (int a = 0; a < 4; ++a) {
                    float vm = (x[4 * a] + x[4 * a + 1]) + (x[4 * a + 2] + 0.5f * x[4 * a + 3]), vs = 0.5f * x[4 * a + 3];
                    vm += __shfl_xor(vm, 1); vm += __shfl_xor(vm, 2); vs += __shfl_xor(vs, 1); vs += __shfl_xor(vs, 2);
                    const int j = (key0 + 32 * sub) / 4 + 2 * a + h;
                    if (head == 0) { __hip_atomic_fetch_add(IMP + tok_l * IMP_PITCH + j, vm, __ATOMIC_RELAXED, __HIP_MEMORY_SCOPE_WORKGROUP);
                        if (j + 1 < NSLC) __hip_atomic_fetch_add(IMP + tok_l * IMP_PITCH + j + 1, vs, __ATOMIC_RELAXED, __HIP_MEMORY_SCOPE_WORKGROUP); }
                }
            }
            if (MODE != 0) {
#pragma unroll
                for (int s = 0; s < 2; ++s) {
                    v4u pw; pw.x = cvtpk(x[8 * s], x[8 * s + 1]); pw.y = cvtpk(x[8 * s + 2], x[8 * s + 3]); pw.z = cvtpk(x[8 * s + 4], x[8 * s + 5]); pw.w = cvtpk(x[8 * s + 6], x[8 * s + 7]);
                    const bf16x8 pf = __builtin_bit_cast(bf16x8, pw);
#pragma unroll
                    for (int dvt = 0; dvt < 2; ++dvt) {
                        const LAS unsigned char* vp = vt + (32 * dvt + r) * VT_PITCH + (32 * sub + 16 * s + 4 * h) * 2;
                        const v2u lo = *(const LAS v2u*)(vp), hi = *(const LAS v2u*)(vp + 16);
                        v4u vw; vw.x = lo.x; vw.y = lo.y; vw.z = hi.x; vw.w = hi.y;
                        O[dvt] = MFMA32(__builtin_bit_cast(bf16x8, vw), pf, O[dvt]);
                    }
                }
            }
        }
        if (more) tile_store<WITH_V>(R, KT + (buf ^ 1) * KT_BYTES, VT + (buf ^ 1) * VT_BYTES, tid);
        __syncthreads();
    }
}

__device__ __forceinline__ void attn_unit(Frame& F, int qt, int g) {
    unsigned char* ws = F.ws;
    LAS unsigned char* lds = F.lds + RING_OFF;
    const bf16* PROJ = (const bf16*)(ws + WS_PROJ); const bf16* QR = (const bf16*)(ws + WS_QR);
    const bf16* KSG = (const bf16*)(ws + WS_KSG) + (size_t)g * T * DQK; const bf16* KWG = (const bf16*)(ws + WS_KWG) + (size_t)g * T * DQK;
    const bf16* VST = (const bf16*)(ws + WS_VST) + (size_t)g * DV * T; const bf16* VWT = (const bf16*)(ws + WS_VWT) + (size_t)g * DV * T;
    const bf16* KCR = (const bf16*)(ws + WS_KCR) + (size_t)g * NCMPP * DQK; const bf16* VCT = (const bf16*)(ws + WS_VCT) + (size_t)g * DV * NCMPP;
    bf16* OB = (bf16*)(ws + WS_O);
    const int tid = F.tid, lane = F.lane, w = F.wave, r = lane & 31, h = lane >> 5, tok_l = 8 * w + (r >> 2), head = r & 3;
    const int t0 = qt * 64, t = t0 + tok_l, hg = 4 * g + head;
    LAS float* IMP = (LAS float*)(lds + L_IMP);
    LAS unsigned short* SEL = (LAS unsigned short*)(lds + L_SEL);
    for (int i = tid; i < 64 * IMP_PITCH; i += 512) IMP[i] = 0.f;
    bf16x8 qf[6];
#pragma unroll
    for (int s = 0; s < 6; ++s) qf[s] = __builtin_bit_cast(bf16x8, *(const GAS v4u*)(QR + (size_t)t * (NH * DQK) + hg * DQK + 16 * s + 8 * h));
    const float g0 = sigmoidf_(bf2f(PROJ[(size_t)t * NP + C_GN + hg * 3 + 0])), g1 = sigmoidf_(bf2f(PROJ[(size_t)t * NP + C_GN + hg * 3 + 1])), g2 = sigmoidf_(bf2f(PROJ[(size_t)t * NP + C_GN + hg * 3 + 2]));
    f32x16 O[2];
#pragma unroll
    for (int i = 0; i < 16; ++i) { O[0][i] = 0.f; O[1][i] = 0.f; }
    float* OACC = (float*)(ws + WS_X1) + (size_t)t * 1024 + hg * DV + 4 * h;
    __syncthreads();
    {
        const int nmax = (t0 + 63 - 31) >> 4, ntiles = (nmax >> 6) + 1;
        float m = NEGBIG, l = 0.f;
        branch<0>(lds, KCR, VCT, NCMPP, 0, ntiles, qf, t, tok_l, head, r, h, tid, m, l, 0.f, O);
        const float lt = l + __shfl_xor(l, 32);
        const float linv = lt > 0.f ? 1.0f / lt : 0.f;
        branch<1>(lds, KCR, VCT, NCMPP, 0, ntiles, qf, t, tok_l, head, r, h, tid, m, l, linv, O);
#pragma unroll
        for (int dvt = 0; dvt < 2; ++dvt)
#pragma unroll
            for (int a = 0; a < 4; ++a) { f32x4 v; v.x = g0 * O[dvt][4 * a]; v.y = g0 * O[dvt][4 * a + 1]; v.z = g0 * O[dvt][4 * a + 2]; v.w = g0 * O[dvt][4 * a + 3];
                *(GAS f32x4*)(OACC + 32 * dvt + 8 * a) = v; }
#pragma unroll
        for (int i = 0; i < 16; ++i) { O[0][i] = 0.f; O[1][i] = 0.f; }
    }
    {
        const int tk = tid >> 3, jj = tid & 7, tt = t0 + tk, cur = tt >> 6;
        float sc[16];
#pragma unroll
        for (int q = 0; q < 16; ++q) { const int j = jj * 16 + q; const bool valid = j <= cur, forced = (j == 0) || (j == cur) || (j == cur - 1);
            sc[q] = valid ? (forced ? 1e30f : IMP[tk * IMP_PITCH + j]) : NEGBIG; }
        __syncthreads();
#pragma unroll
        for (int q = 0; q < 16; ++q) IMP[tk * IMP_PITCH + jj * 16 + q] = sc[q];
        __syncthreads();
        int rank[16];
#pragma unroll
        for (int q = 0; q < 16; ++q) rank[q] = 0;
        for (int jp = 0; jp < NSLC; ++jp) { const float v = IMP[tk * IMP_PITCH + jp];
#pragma unroll
            for (int q = 0; q < 16; ++q) { const int j = jj * 16 + q; rank[q] += (v > sc[q] || (v == sc[q] && jp < j)) ? 1 : 0; } }
        unsigned bits = 0u;
#pragma unroll
        for (int q = 0; q < 16; ++q) { const int j = jj * 16 + q; bits |= ((j <= cur) && rank[q] < NSEL) ? (1u << q) : 0u; }
        SEL[tk * 8 + jj] = (unsigned short)bits;
        __syncthreads();
    }
    {
        float m = NEGBIG, l = 0.f;
        branch<2>(lds, KSG, VST, T, 0, qt + 1, qf, t, tok_l, head, r, h, tid, m, l, 0.f, O);
        const float lt = l + __shfl_xor(l, 32);
        const float sc = lt > 0.f ? g1 / lt : 0.f;
#pragma unroll
        for (int dvt = 0; dvt < 2; ++dvt)
#pragma unroll
            for (int a = 0; a < 4; ++a) { f32x4 v = *(const GAS f32x4*)(OACC + 32 * dvt + 8 * a);
                v.x += sc * O[dvt][4 * a]; v.y += sc * O[dvt][4 * a + 1]; v.z += sc * O[dvt][4 * a + 2]; v.w += sc * O[dvt][4 * a + 3];
                *(GAS f32x4*)(OACC + 32 * dvt + 8 * a) = v; }
#pragma unroll
        for (int i = 0; i < 16; ++i) { O[0][i] = 0.f; O[1][i] = 0.f; }
    }
    {
        const int tile0 = qt >= 8 ? qt - 8 : 0;
        float m = NEGBIG, l = 0.f;
        branch<3>(lds, KWG, VWT, T, tile0, qt - tile0 + 1, qf, t, tok_l, head, r, h, tid, m, l, 0.f, O);
        const float lt = l + __shfl_xor(l, 32);
        const float sc = lt > 0.f ? g2 / lt : 0.f;
#pragma unroll
        for (int dvt = 0; dvt < 2; ++dvt)
#pragma unroll
            for (int a = 0; a < 4; ++a) { const f32x4 v = *(const GAS f32x4*)(OACC + 32 * dvt + 8 * a);
                v2u o; o.x = cvtpk(v.x + sc * O[dvt][4 * a], v.y + sc * O[dvt][4 * a + 1]); o.y = cvtpk(v.z + sc * O[dvt][4 * a + 2], v.w + sc * O[dvt][4 * a + 3]);
                *(GAS v2u*)(OB + (size_t)t * 1024 + hg * DV + 32 * dvt + 8 * a + 4 * h) = o; }
    }
}
__device__ __forceinline__ void p6_attention(Frame& F) {
    for (int u2 = 2 * F.bid; u2 < 512; u2 += ((u2 & 1) ? 2 * F.G - 1 : 1)) {
        const int u = u2 >> 1, g = u & 3, pr = u >> 2;
        attn_unit(F, (u2 & 1) ? 127 - pr : pr, g);
        __syncthreads();
    }
}
#undef MFMA32
}
constexpr int LX_TILE_E = LDS_X;
constexpr int LX_PSTART = LDS_X + 1408;
constexpr int LX_NTILES = LDS_X + 1408 + 272;
static_assert(LX_NTILES + 4 <= LDS_BYTES, "LDS_X");

__device__ __forceinline__ void p9_post_router(Frame& F) {
    unsigned char* ws = F.ws;
    const float* mod = (const float*)(ws + WS_SMALL + SM_MOD);
    const float* Z = (const float*)(ws + WS_Z);
    float* X1 = (float*)(ws + WS_X1);
    bf16* H2HI = (bf16*)(ws + WS_H2HI); bf16* H2LO = (bf16*)(ws + WS_H2LO);
    const bf16* WRH = (const bf16*)(ws + WS_WRT); const bf16* WRL = WRH + 64 * 2048;
    int* SELE = (int*)(ws + WS_TAB + TB_SELE); float* SELW = (float*)(ws + WS_TAB + TB_SELW); int* SELR = (int*)(ws + WS_TAB + TB_SELR);
    unsigned* CNT = (unsigned*)(F.ctl + CW_CNT);
    LAS float* RED = (LAS float*)(F.lds + RING_OFF);
    LAS float* LOG = (LAS float*)(F.lds + RING_OFF + 65536);
    LAS int* LCNT = (LAS int*)(F.lds + RING_OFF + 65536 + 8192);
    LAS int* LBASE = LCNT + 64;
    LAS int* LE = LBASE + 64;
    LAS int* LR = LE + 256;
    const int lane = F.lane, w = F.wave, tid = F.tid;
    for (int rt = F.bid; rt < T / 32; rt += F.G) {
        const int row0 = rt * 32;
        if (tid < 64) LCNT[tid] = 0;
#pragma nounroll
        for (int q = 0; q < 4; ++q) {
            const int row = row0 + 4 * w + q;
            const GAS f32x4* zr = (const GAS f32x4*)(Z + (size_t)row * D) + lane;
            const GAS f32x4* xr = (const GAS f32x4*)(F.x + (size_t)row * D) + lane;
            f32x4 v[8]; float ss = 0.f;
#pragma unroll
            for (int j = 0; j < 8; ++j) { v[j] = zr[64 * j]; ss += (v[j].x * v[j].x + v[j].y * v[j].y) + (v[j].z * v[j].z + v[j].w * v[j].w); }
            const float rstd = 1.0f / sqrtf(wave_sum(ss) * (1.0f / D) + RMS_EPS);
            float s2 = 0.f;
#pragma unroll
            for (int j = 0; j < 8; ++j) { const int col = 4 * (lane + 64 * j);
                const f32x4 g = *(const GAS f32x4*)(F.g_post_mix + col), gt = *(const GAS f32x4*)(mod + 2 * D + col);
                v[j] = xr[64 * j] + gt * ((v[j] * rstd) * g);
                s2 += (v[j].x * v[j].x + v[j].y * v[j].y) + (v[j].z * v[j].z + v[j].w * v[j].w);
                *((GAS f32x4*)(X1 + (size_t)row * D) + lane + 64 * j) = v[j]; }
            const float rstd2 = 1.0f / sqrtf(wave_sum(s2) * (1.0f / D) + RMS_EPS);
#pragma unroll
            for (int j = 0; j < 8; ++j) { const int col = 4 * (lane + 64 * j);
                const f32x4 g = *(const GAS f32x4*)(F.g_pre_ffn + col), sh = *(const GAS f32x4*)(mod + 3 * D + col), sc = *(const GAS f32x4*)(mod + 4 * D + col);
                const f32x4 hv = (v[j] * rstd2) * g * (sc + 1.0f) + sh;
                const unsigned h0 = f2bf(hv.x), h1 = f2bf(hv.y), h2 = f2bf(hv.z), h3 = f2bf(hv.w);
                v2u hi; hi.x = h0 | (h1 << 16); hi.y = h2 | (h3 << 16);
                v2u lo; lo.x = pk2(hv.x - bf2f(h0), hv.y - bf2f(h1)); lo.y = pk2(hv.z - bf2f(h2), hv.w - bf2f(h3));
                *((GAS v2u*)(H2HI + (size_t)row * D) + lane + 64 * j) = hi; *((GAS v2u*)(H2LO + (size_t)row * D) + lane + 64 * j) = lo; }
        }
        VM_WAIT(); __syncthreads();
        {
            const int fr = lane & 15, fq = lane >> 4;
            f32x4 acc[2][4];
#pragma unroll
            for (int a = 0; a < 2; ++a)
#pragma unroll
                for (int b = 0; b < 4; ++b) acc[a][b] = (f32x4){0.f, 0.f, 0.f, 0.f};
#pragma nounroll
            for (int ks = 0; ks < 8; ++ks) {
                const int kof = 256 * w + 32 * ks + 8 * fq;
                bf16x8 ah[2], al[2], bh[4], bl[4];
#pragma unroll
                for (int a = 0; a < 2; ++a) { ah[a] = __builtin_bit_cast(bf16x8, *(const GAS v4u*)(H2HI + (size_t)(row0 + 16 * a + fr) * D + kof)); al[a] = __builtin_bit_cast(bf16x8, *(const GAS v4u*)(H2LO + (size_t)(row0 + 16 * a + fr) * D + kof)); }
#pragma unroll
                for (int b = 0; b < 4; ++b) { bh[b] = __builtin_bit_cast(bf16x8, *(const GAS v4u*)(WRH + (size_t)(16 * b + fr) * D + kof)); bl[b] = __builtin_bit_cast(bf16x8, *(const GAS v4u*)(WRL + (size_t)(16 * b + fr) * D + kof)); }
#pragma unroll
                for (int a = 0; a < 2; ++a)
#pragma unroll
                    for (int b = 0; b < 4; ++b) {
                        acc[a][b] = __builtin_amdgcn_mfma_f32_16x16x32_bf16(ah[a], bh[b], acc[a][b], 0, 0, 0);
                        acc[a][b] = __builtin_amdgcn_mfma_f32_16x16x32_bf16(al[a], bh[b], acc[a][b], 0, 0, 0);
                        acc[a][b] = __builtin_amdgcn_mfma_f32_16x16x32_bf16(ah[a], bl[b], acc[a][b], 0, 0, 0);
                    }
            }
#pragma unroll
            for (int a = 0; a < 2; ++a)
#pragma unroll
                for (int b = 0; b < 4; ++b)
#pragma unroll
                    for (int i = 0; i < 4; ++i) RED[(w * 32 + 16 * a + 4 * fq + i) * 64 + 16 * b + fr] = acc[a][b][i];
        }
        __syncthreads();
        for (int idx = tid; idx < 32 * 64; idx += 512) { float s = 0.f;
#pragma unroll
            for (int ww = 0; ww < NWAVES; ++ww) s += RED[ww * 2048 + idx];
            LOG[idx] = s; }
        __syncthreads();
#pragma nounroll
        for (int q = 0; q < 4; ++q) {
            const int rl = 4 * w + q, row = row0 + rl, e = lane;
            const float aff = 1.0f / (1.0f + __expf(-LOG[rl * 64 + e]));
            const float biased = aff + F.router_bias[e];
            float v1 = biased; int i1 = e;
#pragma unroll
            for (int o = 1; o < 8; o <<= 1) { const float ov = __shfl_xor(v1, o); const int oi = __shfl_xor(i1, o); if (ov > v1 || (ov == v1 && oi < i1)) { v1 = ov; i1 = oi; } }
            float v2 = (e == i1) ? -3.0e38f : biased;
#pragma unroll
            for (int o = 1; o < 8; o <<= 1) v2 = fmaxf(v2, __shfl_xor(v2, o));
            const float gs = v1 + v2; const int mg = e >> 3;
            int grank = 0;
#pragma unroll
            for (int gp = 0; gp < 8; ++gp) { const float og = __shfl(gs, gp * 8); grank += (og > gs || (og == gs && gp < mg)) ? 1 : 0; }
            const float s = (grank < 4) ? biased : -1e30f;
            int rank = 0;
            for (int ep = 0; ep < 64; ++ep) { const float ov = __shfl(s, ep); rank += (ov > s || (ov == s && ep < e)) ? 1 : 0; }
            const bool sel = rank < TOPK;
            const float wsum = wave_sum(sel ? aff : 0.f);
            if (sel) { const int lr = __hip_atomic_fetch_add(LCNT + e, 1, __ATOMIC_RELAXED, __HIP_MEMORY_SCOPE_WORKGROUP);
                LE[rl * 8 + rank] = e; LR[rl * 8 + rank] = lr;
                SELE[(size_t)row * 8 + rank] = e; SELW[(size_t)row * 8 + rank] = aff / wsum * 2.5f; }
        }
        __syncthreads();
        if (tid < 64) LBASE[tid] = (int)__hip_atomic_fetch_add(CNT + tid, (unsigned)LCNT[tid], __ATOMIC_RELAXED, __HIP_MEMORY_SCOPE_AGENT);
        __syncthreads();
        if (tid < 256) SELR[(size_t)row0 * 8 + tid] = LBASE[LE[tid]] + LR[tid];
        __syncthreads();
    }
}

__device__ __forceinline__ void p10_tables(Frame& F) {
    unsigned char* ws = F.ws;
    const int* SELE = (const int*)(ws + WS_TAB + TB_SELE); const float* SELW = (const float*)(ws + WS_TAB + TB_SELW); const int* SELR = (const int*)(ws + WS_TAB + TB_SELR);
    int* POS = (int*)(ws + WS_TAB + TB_POS); int* TOK = (int*)(ws + WS_TAB + TB_TOK); float* WROW = (float*)(ws + WS_TAB + TB_WROW);
    unsigned* CNT = (unsigned*)(F.ctl + CW_CNT);
    LAS int* tile_e = (LAS int*)(F.lds + LX_TILE_E); LAS int* pstart = (LAS int*)(F.lds + LX_PSTART); LAS int* ntl = (LAS int*)(F.lds + LX_NTILES);
    if (F.tid == 0) {
        int tiles = 0;
        for (int e = 0; e < NE; ++e) { const int c = (int)__hip_atomic_load(CNT + e, __ATOMIC_RELAXED, __HIP_MEMORY_SCOPE_AGENT); const int nt = (c + 255) >> 8;
            pstart[e] = tiles * 256; for (int q = 0; q < nt; ++q) tile_e[tiles + q] = e; tiles += nt; }
        pstart[NE] = tiles * 256; for (int q = 0; q < 32; ++q) tile_e[tiles + q] = NE; tiles += 32;
        pstart[NE + 1] = tiles * 256; ntl[0] = tiles;
    }
    __syncthreads();
    const int gt = F.bid * 512 + F.tid, NT = F.G * 512;
    for (int idx = gt; idx < T * TOPK; idx += NT) { const int e = SELE[idx], pos = pstart[e] + SELR[idx]; TOK[pos] = idx >> 3; WROW[pos] = SELW[idx]; POS[idx] = pos; }
    for (int t = gt; t < T; t += NT) { TOK[pstart[NE] + t] = t; WROW[pstart[NE] + t] = 1.0f; }
    for (int e = F.bid; e < NE; e += F.G) { const int c = (int)__hip_atomic_load(CNT + e, __ATOMIC_RELAXED, __HIP_MEMORY_SCOPE_AGENT);
        for (int s = pstart[e] + c + F.tid; s < pstart[e + 1]; s += 512) { TOK[s] = 0; WROW[s] = 0.f; } }
}

__device__ __forceinline__ void p13_final(Frame& F) {
    unsigned char* ws = F.ws;
    const float* mod = (const float*)(ws + WS_SMALL + SM_MOD);
    const float* X1 = (const float*)(ws + WS_X1); const bf16* YB = (const bf16*)(ws + WS_YB);
    const int* POS = (const int*)(ws + WS_TAB + TB_POS);
    const LAS int* pstart = (const LAS int*)(F.lds + LX_PSTART);
    const int gw = F.bid * NWAVES + F.wave, NGW = F.G * NWAVES, lane = F.lane;
    const int shbase = pstart[NE];
    for (int row = gw; row < T; row += NGW) {
        float y[4][8];
#pragma unroll
        for (int j = 0; j < 4; ++j)
#pragma unroll
            for (int i = 0; i < 8; ++i) y[j][i] = 0.f;
        for (int k = 0; k < TOPK + 1; ++k) {
            const int slot = (k < TOPK) ? POS[(size_t)row * 8 + k] : shbase + row;
            const bf16* yr = YB + (size_t)slot * D;
#pragma unroll
            for (int j = 0; j < 4; ++j) { float a[8]; unpack8(*(const GAS v4u*)(yr + 8 * (lane + 64 * j)), a);
#pragma unroll
                for (int i = 0; i < 8; ++i) y[j][i] += a[i]; }
        }
        float ss = 0.f;
#pragma unroll
        for (int j = 0; j < 4; ++j)
#pragma unroll
            for (int i = 0; i < 8; ++i) ss += y[j][i] * y[j][i];
        const float rstd = 1.0f / sqrtf(wave_sum(ss) * (1.0f / D) + RMS_EPS);
#pragma unroll
        for (int j = 0; j < 4; ++j) { const int col = 8 * (lane + 64 * j);
#pragma unroll
            for (int hh = 0; hh < 2; ++hh) {
                const f32x4 x1 = *(const GAS f32x4*)(X1 + (size_t)row * D + col + 4 * hh), g = *(const GAS f32x4*)(F.g_post_ffn + col + 4 * hh), gt = *(const GAS f32x4*)(mod + 5 * D + col + 4 * hh);
                f32x4 yy; yy.x = y[j][4 * hh]; yy.y = y[j][4 * hh + 1]; yy.z = y[j][4 * hh + 2]; yy.w = y[j][4 * hh + 3];
                *(GAS f32x4*)(F.out + (size_t)row * D + col + 4 * hh) = x1 + gt * ((yy * rstd) * g); } }
    }
}
struct Args { const void* in[29]; float* out; unsigned char* ws; };
__global__ void __launch_bounds__(NWAVES * 64, 2) fwd_kernel(Args args) {
    extern __shared__ __attribute__((aligned(16))) unsigned char lds[];
    Frame F;
    F.lds = (LAS unsigned char*)lds;
    F.MISC = (volatile LAS unsigned*)(F.lds + MISC_OFF);
    F.tid = threadIdx.x; F.lane = F.tid & 63; F.wave = __builtin_amdgcn_readfirstlane(F.tid >> 6);
    F.G = gridDim.x; F.bid = blockIdx.x;
    unsigned char* ws = args.ws; F.ws = ws;
    F.ctl = (gu32*)(ws + WS_CTL);
    F.x = (const float*)args.in[0]; F.c = (const float*)args.in[1]; F.positions = (const int*)args.in[2];
    F.w_ada = (const float*)args.in[3]; F.b_ada = (const float*)args.in[4];
    F.g_pre_mix = (const float*)args.in[5]; F.g_post_mix = (const float*)args.in[6]; F.g_pre_ffn = (const float*)args.in[7]; F.g_post_ffn = (const float*)args.in[8];
    F.w_in = (const float*)args.in[9];
    F.cmp_pos_k = (const float*)args.in[10]; F.cmp_k_w1 = (const float*)args.in[11]; F.cmp_k_w2 = (const float*)args.in[12];
    F.cmp_pos_v = (const float*)args.in[13]; F.cmp_v_w1 = (const float*)args.in[14]; F.cmp_v_w2 = (const float*)args.in[15];
    F.pool_w = (const float*)args.in[16]; F.pool_scale = (const float*)args.in[17];
    F.w_pool_up = (const float*)args.in[18]; F.w_nsa_up = (const float*)args.in[19]; F.w_out = (const float*)args.in[20];
    F.w_router = (const float*)args.in[21]; F.router_bias = (const float*)args.in[22];
    F.w_exp_gate = (const float*)args.in[23]; F.w_exp_up = (const float*)args.in[24]; F.w_exp_down = (const float*)args.in[25];
    F.w_sh_gate = (const float*)args.in[26]; F.w_sh_up = (const float*)args.in[27]; F.w_sh_down = (const float*)args.in[28];
    F.out = args.out;
    for (int u = F.tid; u < (LDS_BYTES - LDSCTL_OFF) / 4; u += NWAVES * 64) ((LAS unsigned*)(F.lds + LDSCTL_OFF))[u] = 0u;
    __syncthreads();
    XcdBarrier bar = xcd_barrier_post((unsigned*)(F.ctl + CW_BAR), F.MISC + 8);
#define GRID_BAR() do { xcd_barrier(bar); int _t = threadIdx.x; asm volatile("" : "+v"(_t)); F.tid = _t; F.lane = _t & 63; F.wave = __builtin_amdgcn_readfirstlane(_t >> 6); } while (0)
    LAS unsigned char* ring = F.lds + RING_OFF;

#if PH_HI > 0 && PH_LO <= 0
    p0_prologue(F);
    GRID_BAR();
#endif
#if PH_HI > 1 && PH_LO <= 1
    p1_norm(F);
    GRID_BAR();
#endif
#if PH_HI > 2 && PH_LO <= 2
    {
        pg8::Gemm g{(const bf16*)(ws + WS_H), 2048, 2048};
        SchedPlain S{32, 34, F.G, F.bid, (const char*)(ws + WS_WIN), 4096u, 4096};
        EpiBf16 E{(bf16*)(ws + WS_PROJ), NP, 0, 0};
        pg8::gemm_phase<EpiBf16, SchedPlain>(ring, g, S, E);
    }
    GRID_BAR();
#endif
#if PH_HI > 3 && PH_LO <= 3
    p3_relayout(F);
    GRID_BAR();
#endif
#if PH_HI > 4 && PH_LO <= 4
    {
        pg8::Gemm g{(const bf16*)(ws + WS_DPOOL), 256, 256};
        SchedPool S{F.G, F.bid, (const char*)(ws + WS_WPOOL)};
        EpiBf16 E{(bf16*)(ws + WS_APOOL), 1024, 0, 256};
        pg8::gemm_phase<EpiBf16, SchedPool>(ring, g, S, E);
    }
    {
        pg8::Gemm g{(const bf16*)(ws + WS_KCG), 3072, 768};
        SchedSplitK S{2, F.G, (F.bid + F.G - 128 % F.G) % F.G, (const char*)(ws + WS_WCK), 3072u, 6144, 768};
        EpiF32 E{(float*)(ws + WS_PARTK), 512, (size_t)2048 * 512};
        pg8::gemm_phase<EpiF32, SchedSplitK>(ring, g, S, E);
    }
    {
        pg8::Gemm g{(const bf16*)(ws + WS_VCG), 2048, 512};
        SchedSplitK S{1, F.G, (F.bid + F.G - 192 % F.G) % F.G, (const char*)(ws + WS_WCV), 2048u, 4096, 512};
        EpiF32 E{(float*)(ws + WS_PARTV), 256, (size_t)2048 * 256};
        pg8::gemm_phase<EpiF32, SchedSplitK>(ring, g, S, E);
    }
    GRID_BAR();
#endif
#if PH_HI > 5 && PH_LO <= 5
    p5_cmp2(F);
    __syncthreads();
    {
        pg8::Gemm g{(const bf16*)(ws + WS_APOOL), 1024, 1024};
        SchedPlain S{32, 8, F.G, F.bid, (const char*)(ws + WS_WPU), 2048u, 2048};
        EpiGate<false> E{(bf16*)(ws + WS_YPART), nullptr, (const bf16*)(ws + WS_PROJ), C_GM};
        pg8::gemm_phase<EpiGate<false>, SchedPlain>(ring, g, S, E);
    }
    GRID_BAR();
#endif
#if PH_HI > 6 && PH_LO <= 6
    nsa::p6_attention(F);
    GRID_BAR();
#endif
#if PH_HI > 7 && PH_LO <= 7
    {
        pg8::Gemm g{(const bf16*)(ws + WS_O), 1024, 1024};
        SchedPlain S{32, 8, F.G, F.bid, (const char*)(ws + WS_WNU), 2048u, 2048};
        EpiGate<true> E{(bf16*)(ws + WS_Y), (const bf16*)(ws + WS_YPART), (const bf16*)(ws + WS_PROJ), C_GM + 2048};
        pg8::gemm_phase<EpiGate<true>, SchedPlain>(ring, g, S, E);
    }
    GRID_BAR();
#endif
#if PH_HI > 8 && PH_LO <= 8
    {
        pg8::Gemm g{(const bf16*)(ws + WS_Y), 2048, 2048};
        SchedPlain S{32, 8, F.G, F.bid, (const char*)(ws + WS_WOUT), 4096u, 4096};
        EpiF32 E{(float*)(ws + WS_Z), 2048, 0};
        pg8::gemm_phase<EpiF32, SchedPlain>(ring, g, S, E);
    }
    GRID_BAR();
#endif
#if PH_HI > 9 && PH_LO <= 9
    p9_post_router(F);
    GRID_BAR();
#endif
#if PH_HI > 10 && PH_LO <= 10
    p10_tables(F);
    GRID_BAR();
#endif
#if PH_HI > 11 && PH_LO <= 11
    {
        const LAS int* tile_e = (const LAS int*)(F.lds + LX_TILE_E); const int ntiles = *(const LAS int*)(F.lds + LX_NTILES);
        pg8::Gemm g{(const bf16*)(ws + WS_H2HI), 2048, 2048};
        SchedMoe1 S{F.G, F.bid, ntiles, tile_e, (const int*)(ws + WS_TAB + TB_TOK), (const char*)(ws + WS_W1)};
        EpiMoe1 E{(bf16*)(ws + WS_HID)};
        pg8::gemm_phase<EpiMoe1, SchedMoe1>(ring, g, S, E);
    }
    GRID_BAR();
#endif
#if PH_HI > 12 && PH_LO <= 12
    {
        const LAS int* tile_e = (const LAS int*)(F.lds + LX_TILE_E); const int ntiles = *(const LAS int*)(F.lds + LX_NTILES);
        pg8::Gemm g{(const bf16*)(ws + WS_HID), 512, 512};
        SchedMoe2 S{F.G, F.bid, ntiles, tile_e, (const char*)(ws + WS_W2)};
        EpiMoe2 E{(bf16*)(ws + WS_YB), (const float*)(ws + WS_TAB + TB_WROW)};
        pg8::gemm_phase<EpiMoe2, SchedMoe2>(ring, g, S, E);
    }
    GRID_BAR();
#endif
#if PH_HI > 13 && PH_LO <= 13
    p13_final(F);
#endif
}

extern "C" void kernel_launch(void* const* d_in, const int* in_sizes, int n_in, void* d_out, int out_size, void* d_ws, size_t ws_size, hipStream_t stream) {
    static int grid = 0;
    if (grid == 0) {
        if (n_in != 29 || in_sizes[0] != T * D || out_size != T * D || ws_size < WS_END) { fprintf(stderr, "kernel_launch: unexpected shapes (n_in %d, in0 %d, out %d, ws %zu, need %zu)\n", n_in, n_in > 0 ? in_sizes[0] : -1, out_size, ws_size, (size_t)WS_END); grid = -1; return; }
        int dev = 0, cus = 0, per_cu = 0;
        if (hipGetDevice(&dev) != hipSuccess || hipDeviceGetAttribute(&cus, hipDeviceAttributeMultiprocessorCount, dev) != hipSuccess) { grid = -1; return; }
        if (hipFuncSetAttribute((const void*)fwd_kernel, hipFuncAttributeMaxDynamicSharedMemorySize, LDS_BYTES) != hipSuccess) { fprintf(stderr, "kernel_launch: hipFuncSetAttribute failed\n"); grid = -1; return; }
        if (hipOccupancyMaxActiveBlocksPerMultiprocessor(&per_cu, (const void*)fwd_kernel, NWAVES * 64, LDS_BYTES) != hipSuccess || per_cu < 1) { fprintf(stderr, "kernel_launch: occupancy query reports %d\n", per_cu); }
        (void)hipGetLastError();
        grid = cus;
    }
    if (grid < 0) return;
    if (hipMemsetAsync((char*)d_ws + WS_CTL, 0, CTL_ZERO_BYTES, stream) != hipSuccess) return;
    Args a{};
    for (int i = 0; i < 29; ++i) a.in[i] = d_in[i];
    a.out = (float*)d_out; a.ws = (unsigned char*)d_ws;
    hipLaunchKernelGGL(fwd_kernel, dim3(grid), dim3(NWAVES * 64), LDS_BYTES, stream, a);
}
```

```cpp
#include <hip/hip_runtime.h>
#include <cstdio>
#include <cstdint>

namespace pg8 {
#define PG8_LAS __attribute__((address_space(3)))
typedef unsigned short bf16_t;
typedef short bf16x8 __attribute__((ext_vector_type(8)));
typedef float f32x4 __attribute__((ext_vector_type(4)));
typedef float f32x2 __attribute__((ext_vector_type(2)));
typedef unsigned u32x4 __attribute__((ext_vector_type(4)));
typedef unsigned u32x2 __attribute__((ext_vector_type(2)));
constexpr int BM = 256, BK = 64, HALF = 128, HTB = HALF * BK * 2, STAGE_BYTES = 8 * HTB, NXCD = 8, WGM = 8;

__host__ __device__ __forceinline__ int lds_byte(int r, int c) { const int st = (r >> 4) * 2 + (c >> 5), rr = r & 15, cc = c & 31, ob = rr * 64 + cc * 2; return st * 1024 + (ob ^ (((ob >> 9) & 1) << 5)); }
__host__ __device__ __forceinline__ void stage_rc(int b, int& R, int& C) { const int st = b / 1024, sb = b % 1024, swz = sb ^ (((sb >> 9) & 1) << 5); R = (st >> 1) * 16 + swz / 64; C = (st & 1) * 32 + (swz % 64) / 2; }
__host__ __device__ __forceinline__ int perm32(int rho) { const int n = rho >> 4, i = rho & 15; return 8 * (i >> 2) + 4 * n + (i & 3); }

struct Unit { int pm, pn, aux; };
struct Gemm { const bf16_t* A; int ldb, K; };

__device__ __forceinline__ bool static_tile(int i, int G, int c, int nM, int nN, int& pm, int& pn) {
    const int nwg = nM * nN; const long L = (long)i * G + c; if (L >= nwg) return false;
    int wgid = (int)L; { const int q = nwg / NXCD, r = nwg % NXCD, xcd = wgid % NXCD, off = wgid / NXCD; wgid = (xcd < r ? xcd * (q + 1) : r * (q + 1) + (xcd - r) * q) + off; }
    const int nig = WGM * nN, gid = wgid / nig, fm = gid * WGM, gsz = (nM - fm) < WGM ? (nM - fm) : WGM;
    pm = fm + ((wgid % nig) % gsz); pn = (wgid % nig) / gsz; return true;
}
__device__ __forceinline__ unsigned cvt_pk_bf16(float lo, float hi) { unsigned r; asm volatile("v_cvt_pk_bf16_f32 %0, %1, %2" : "=v"(r) : "v"(lo), "v"(hi)); return r; }

template <class Epi, class Sched, bool ALIGN_EPI = true>
__device__ __forceinline__ void gemm_phase(PG8_LAS unsigned char* lds, const Gemm g, const Sched& S, const Epi& E) {
    int tid = threadIdx.x; asm volatile("" : "+v"(tid));
    const int wid = __builtin_amdgcn_readfirstlane(tid >> 6), lane = tid & 63, wr = wid >> 2, wc = wid & 3, fr = lane & 15, fq = lane >> 4;
    const int nt = g.K / BK;
    int Rst[2], Cst[2]; unsigned voffB[2];
#pragma unroll
    for (int i = 0; i < 2; ++i) { int R, C; stage_rc(tid * 16 + i * 8192, R, C); const int Rb = Epi::PERM ? ((R & ~31) + perm32(R & 31)) : R;
        Rst[i] = R; Cst[i] = C; voffB[i] = (unsigned)(Rb * g.ldb + C) * 2u; }
    const unsigned kstep = (unsigned)(BK * 2);
    const size_t hstepB = (size_t)HALF * g.ldb * 2;
    const unsigned ldsw = (unsigned)wid * 1024u;
    const int aoff = lds_byte(wr * 64 + fr, fq * 8), boff = lds_byte(wc * 32 + fr, fq * 8);
    const char* Ab = (const char*)g.A;
#define PG8_SA(b, h) (((b) * 2 + (h)) * HTB)
#define PG8_SB(b, h) ((4 + (b) * 2 + (h)) * HTB)
#define PG8_STAGEB(bufoff, gbase) do { _Pragma("unroll") for (int _i = 0; _i < 2; ++_i) \
        __builtin_amdgcn_global_load_lds((const unsigned*)((const char*)(gbase) + voffB[_i]), (PG8_LAS unsigned*)(lds + (bufoff) + ldsw + _i * 8192), 16, 0, 0); } while (0)
#define PG8_STAGEA(bufoff, vo0, vo1, kb) do { \
        __builtin_amdgcn_global_load_lds((const unsigned*)(Ab + (size_t)(vo0) + (kb)), (PG8_LAS unsigned*)(lds + (bufoff) + ldsw), 16, 0, 0); \
        __builtin_amdgcn_global_load_lds((const unsigned*)(Ab + (size_t)(vo1) + (kb)), (PG8_LAS unsigned*)(lds + (bufoff) + ldsw + 8192), 16, 0, 0); } while (0)
#define PG8_LDA(dst, b, h) do { _Pragma("unroll") for (int m = 0; m < 4; ++m) _Pragma("unroll") for (int k = 0; k < 2; ++k) dst[m][k] = *(const PG8_LAS bf16x8*)(lds + PG8_SA(b, h) + aoff + m * 2048 + k * 1024); } while (0)
#define PG8_LDB(dst, b, h) do { _Pragma("unroll") for (int n = 0; n < 2; ++n) _Pragma("unroll") for (int k = 0; k < 2; ++k) dst[n][k] = *(const PG8_LAS bf16x8*)(lds + PG8_SB(b, h) + boff + n * 2048 + k * 1024); } while (0)
#if defined(ABL_GEMM)
#define PG8_MMA(ai, bj, At, Bt) do { asm volatile("" :: "v"(At[0][0]), "v"(Bt[0][0])); } while (0)
#else
#define PG8_MMA(ai, bj, At, Bt) do { __builtin_amdgcn_s_setprio(1); _Pragma("unroll") for (int m = 0; m < 4; ++m) _Pragma("unroll") for (int n = 0; n < 2; ++n) _Pragma("unroll") for (int k = 0; k < 2; ++k) \
        acc[ai][bj][m][n] = __builtin_amdgcn_mfma_f32_16x16x32_bf16(Bt[n][k], At[m][k], acc[ai][bj][m][n], 0, 0, 0); __builtin_amdgcn_s_setprio(0); } while (0)
#endif
#define PG8_WAIT_V(n) asm volatile("s_waitcnt vmcnt(" #n ")" ::: "memory")
#define PG8_WAIT_L(n) asm volatile("s_waitcnt lgkmcnt(" #n ")" ::: "memory")
#define PG8_BAR __builtin_amdgcn_s_barrier()
#define PG8_SCHED __builtin_amdgcn_sched_barrier(0)
    Unit cur, nxt; int ui = 0;
    if (!S.next(0, cur)) return;
    f32x4 acc[2][2][4][2];
#pragma unroll
    for (int a = 0; a < 2; ++a)
#pragma unroll
        for (int b = 0; b < 2; ++b)
#pragma unroll
            for (int m = 0; m < 4; ++m)
#pragma unroll
                for (int n = 0; n < 2; ++n) acc[a][b][m][n] = (f32x4){0.f, 0.f, 0.f, 0.f};
    bf16x8 At[4][2], B0[2][2], B1[2][2];
    unsigned c00, c01, c10, c11, n00, n01, n10, n11;
    c00 = S.aoff(cur, Rst[0]) + (unsigned)Cst[0] * 2u; c01 = S.aoff(cur, Rst[1]) + (unsigned)Cst[1] * 2u;
    c10 = S.aoff(cur, HALF + Rst[0]) + (unsigned)Cst[0] * 2u; c11 = S.aoff(cur, HALF + Rst[1]) + (unsigned)Cst[1] * 2u;
    const char* cB = S.bptr(cur);
    PG8_WAIT_V(0);
    PG8_STAGEB(PG8_SB(0, 0), cB); PG8_STAGEB(PG8_SB(0, 1), cB + hstepB); PG8_STAGEA(PG8_SA(0, 0), c00, c01, 0u); PG8_STAGEA(PG8_SA(0, 1), c10, c11, 0u);
    if (wr == 1) PG8_BAR;
    PG8_WAIT_V(2); PG8_BAR;
    PG8_STAGEB(PG8_SB(1, 0), cB + kstep); PG8_STAGEA(PG8_SA(1, 0), c00, c01, kstep); PG8_STAGEB(PG8_SB(1, 1), cB + hstepB + kstep);
    PG8_WAIT_V(6); PG8_BAR;
    for (;;) {
        const bool has_next = S.next(ui + 1, nxt);
        const char* nB = cB; n00 = c00; n01 = c01; n10 = c10; n11 = c11;
        if (has_next) {
            nB = S.bptr(nxt);
            n00 = S.aoff(nxt, Rst[0]) + (unsigned)Cst[0] * 2u; n01 = S.aoff(nxt, Rst[1]) + (unsigned)Cst[1] * 2u;
            n10 = S.aoff(nxt, HALF + Rst[0]) + (unsigned)Cst[0] * 2u; n11 = S.aoff(nxt, HALF + Rst[1]) + (unsigned)Cst[1] * 2u;
        }
#pragma nounroll
        for (int t = 0; t < nt; t += 2) {
            const bool last = (t == nt - 2);
            const unsigned k1 = (unsigned)(t + 1) * kstep;
            const unsigned k2 = last ? 0u : (unsigned)(t + 2) * kstep, k3 = k2 + kstep;
            const char* b2 = last ? nB : cB;
            const unsigned a00 = last ? n00 : c00, a01 = last ? n01 : c01, a10 = last ? n10 : c10, a11 = last ? n11 : c11;
            PG8_LDB(B0, 0, 0); PG8_LDB(B1, 0, 1); PG8_SCHED; PG8_LDA(At, 0, 0); PG8_STAGEA(PG8_SA(1, 1), c10, c11, k1);
            PG8_WAIT_V(8); PG8_WAIT_L(0); PG8_BAR; PG8_MMA(0, 0, At, B0); PG8_MMA(0, 1, At, B1); PG8_BAR; PG8_SCHED;
            PG8_LDA(At, 0, 1); PG8_STAGEB(PG8_SB(0, 0), b2 + k2); PG8_STAGEB(PG8_SB(0, 1), b2 + hstepB + k2); PG8_STAGEA(PG8_SA(0, 0), a00, a01, k2);
            PG8_WAIT_V(8); PG8_WAIT_L(0); PG8_BAR; PG8_MMA(1, 0, At, B0); PG8_MMA(1, 1, At, B1); PG8_BAR; PG8_SCHED;
            PG8_LDB(B0, 1, 0); PG8_LDB(B1, 1, 1); PG8_SCHED; PG8_LDA(At, 1, 0); PG8_STAGEA(PG8_SA(0, 1), a10, a11, k2);
            PG8_WAIT_V(8); PG8_WAIT_L(0); PG8_BAR; PG8_MMA(0, 0, At, B0); PG8_MMA(0, 1, At, B1); PG8_BAR; PG8_SCHED;
            PG8_LDA(At, 1, 1); PG8_STAGEB(PG8_SB(1, 0), b2 + k3); PG8_STAGEB(PG8_SB(1, 1), b2 + hstepB + k3); PG8_STAGEA(PG8_SA(1, 0), a00, a01, k3);
            PG8_WAIT_V(8); PG8_WAIT_L(0); PG8_BAR; PG8_MMA(1, 0, At, B0); PG8_MMA(1, 1, At, B1); PG8_BAR; PG8_SCHED;
        }
        if constexpr (ALIGN_EPI) { if (wr == 0) PG8_BAR; }
        E(acc, cur, wr, wc, fr, fq);
        if (!has_next) break;
#pragma unroll
        for (int a = 0; a < 2; ++a)
#pragma unroll
            for (int b = 0; b < 2; ++b)
#pragma unroll
                for (int m = 0; m < 4; ++m)
#pragma unroll
                    for (int n = 0; n < 2; ++n) acc[a][b][m][n] = (f32x4){0.f, 0.f, 0.f, 0.f};
        cur = nxt; cB = nB; c00 = n00; c01 = n01; c10 = n10; c11 = n11; ++ui;
        if constexpr (ALIGN_EPI) { if (wr == 1) PG8_BAR; }
    }
    PG8_WAIT_V(0);
    if constexpr (!ALIGN_EPI) { if (wr == 0) PG8_BAR; }
    PG8_BAR;
#undef PG8_SA
#undef PG8_SB
#undef PG8_STAGEA
#undef PG8_STAGEB
#undef PG8_LDA
#undef PG8_LDB
#undef PG8_MMA
#undef PG8_WAIT_V
#undef PG8_WAIT_L
#undef PG8_BAR
#undef PG8_SCHED
}
}
#ifndef PH_HI
#define PH_HI 14
#endif
#define REP_PHASE -1
#define REP_EXTRA 1
#define CONV_P0 (1 << 20)
#define CONV_P2 0
#define P11_C F.bid
#ifndef PH_LO
#define PH_LO 0
#endif
constexpr int T = 8192, D = 2048;
constexpr int NP = 8704;
constexpr int IN_COLS = 8624;
constexpr int C_U = 0, C_Q = 1024, C_KC = 2560, C_VC = 2944, C_KS = 3200, C_VS = 3584, C_KW = 3840, C_VW = 4224, C_GN = 4480, C_GM = 4528;
constexpr int NH = 16, NG = 4, DQK = 96, DV = 64, ROT = 24, HALFROT = 12;
constexpr int NCMP = 511, NCMPP = 512, NSLC = 128, NSEL = 16, WIN = 512;
constexpr int NE = 64, NE1 = 65, TOPK = 8, DE = 512;
constexpr int MAXTILES = 352;
constexpr float RMS_EPS = 1e-6f;
constexpr int NWAVES = 8;

constexpr size_t MiB = 1u << 20;
constexpr size_t WS_CTL = 0, CTL_ZERO_BYTES = 32768;
constexpr size_t WS_WIN = 1 * MiB;
constexpr size_t WS_WOUT = 35 * MiB;
constexpr size_t WS_WPU = 43 * MiB;
constexpr size_t WS_WNU = 47 * MiB;
constexpr size_t WS_WCK = 51 * MiB;
constexpr size_t WS_WCV = 54 * MiB;
constexpr size_t WS_WPOOL = 55 * MiB;
constexpr size_t WS_WRT = 55 * MiB + 512 * 1024;
constexpr size_t WS_W1 = 56 * MiB;
constexpr size_t WS_W2 = 316 * MiB;
constexpr size_t WS_SMALL = 446 * MiB;
constexpr size_t SM_MOD = 0;
constexpr size_t SM_BIASK = 65536;
constexpr size_t SM_BIASV = 65536 + 2048;
constexpr size_t SM_ROPE = 131072;
constexpr size_t SM_END = 131072 + 786432;
constexpr size_t SM_KNS = SM_END + 4096;
constexpr size_t SM_KNW = SM_KNS + 4096;
constexpr size_t SM_KNC = SM_KNW + 4096;
constexpr size_t WS_ACT = 448 * MiB;
constexpr size_t WS_X1 = WS_ACT;
constexpr size_t WS_H2HI = WS_ACT + 64 * MiB;
constexpr size_t WS_H2LO = WS_ACT + 96 * MiB;
constexpr size_t WS_OV = WS_ACT + 128 * MiB;
constexpr size_t WS_HID = WS_OV;
constexpr size_t WS_YB = WS_OV + 88 * MiB;
constexpr size_t WS_PROJ = WS_OV;
constexpr size_t WS_QR = WS_OV + 136 * MiB;
constexpr size_t WS_KSG = WS_OV + 160 * MiB;
constexpr size_t WS_KWG = WS_OV + 166 * MiB;
constexpr size_t WS_KCG = WS_OV + 172 * MiB;
constexpr size_t WS_VCG = WS_OV + 179 * MiB;
constexpr size_t WS_VST = WS_OV + 184 * MiB;
constexpr size_t WS_VWT = WS_OV + 188 * MiB;
constexpr size_t WS_DPOOL = WS_OV + 192 * MiB;
constexpr size_t WS_APOOL = WS_OV + 208 * MiB;
constexpr size_t WS_PARTK = WS_OV + 224 * MiB;
constexpr size_t WS_PARTV = WS_OV + 240 * MiB;
constexpr size_t WS_KCR = WS_OV + 248 * MiB;
constexpr size_t WS_VCT = WS_OV + 248 * MiB + 512 * 1024;
constexpr size_t WS_YPART = WS_OV + 249 * MiB;
constexpr size_t WS_O = WS_OV + 281 * MiB;
constexpr size_t WS_Y = WS_OV + 297 * MiB;
constexpr size_t WS_Z = WS_OV + 329 * MiB;
constexpr size_t WS_H = WS_OV + 393 * MiB;
constexpr size_t WS_TAB = WS_OV + 440 * MiB;
constexpr size_t TB_SELE = 0;
constexpr size_t TB_SELW = 262144;
constexpr size_t TB_SELR = 524288;
constexpr size_t TB_POS = 786432;
constexpr size_t TB_TOK = 1048576;
constexpr size_t TB_WROW = 1048576 + 524288;
constexpr size_t WS_END = WS_TAB + 4 * MiB;
static_assert(WS_END <= 1024 * MiB, "ws map");
static_assert(WS_YB + (size_t)MAXTILES * 256 * 2048 * 2 <= WS_TAB, "YB");
constexpr int CW_BAR = 0;
constexpr int CW_CNT = 4096;

constexpr int RING_OFF = 0, RING_BYTES = 131072;
constexpr int LDSCTL_OFF = RING_BYTES, MISC_OFF = LDSCTL_OFF + 320;
constexpr int LDS_BYTES = 147456;
constexpr int LDS_X = MISC_OFF + 128;

#define GAS __attribute__((address_space(1)))
#define LAS __attribute__((address_space(3)))
typedef unsigned short bf16;
typedef unsigned v4u __attribute__((ext_vector_type(4)));
typedef unsigned v2u __attribute__((ext_vector_type(2)));
typedef float f32x4 __attribute__((ext_vector_type(4)));
typedef float f32x16 __attribute__((ext_vector_type(16)));
typedef short bf16x8 __attribute__((ext_vector_type(8)));
typedef short s16x4 __attribute__((ext_vector_type(4)));
typedef GAS unsigned gu32;
#define RLX_AGENT __ATOMIC_RELAXED, __HIP_MEMORY_SCOPE_AGENT
#define LDS_WAIT() asm volatile("s_waitcnt lgkmcnt(0)" ::: "memory")
#define VM_WAIT() asm volatile("s_waitcnt vmcnt(0)" ::: "memory")
__device__ __forceinline__ unsigned f2bf(float f) { unsigned u = __builtin_bit_cast(unsigned, f); return (u + 0x7fffu + ((u >> 16) & 1u)) >> 16; }
__device__ __forceinline__ unsigned pk2(float lo, float hi) { return f2bf(lo) | (f2bf(hi) << 16); }
__device__ __forceinline__ float bf2f(unsigned b) { return __builtin_bit_cast(float, b << 16); }
__device__ __forceinline__ float bflo(unsigned w) { return __builtin_bit_cast(float, w << 16); }
__device__ __forceinline__ float bfhi(unsigned w) { return __builtin_bit_cast(float, w & 0xffff0000u); }
__device__ __forceinline__ float sigmoidf_(float v) { return 1.0f / (1.0f + __expf(-v)); }

#define XB_TMO      128
#define XB_XCNT(j)  (256  + 64 * (j))
#define XB_XSUB(j)  (1280 + 64 * (j))
#define XB_XGEN(j)  (2304 + 64 * (j))
#define XB_TOP      3328
#define XB_TOPGEN   3392
#define XCD_BAR_WORDS 3456
#define XB_SPIN_CAP (1u << 18)
__device__ __forceinline__ unsigned xb_ld(unsigned* p)              { return __hip_atomic_load(p, __ATOMIC_RELAXED, __HIP_MEMORY_SCOPE_AGENT); }
__device__ __forceinline__ unsigned xb_add(unsigned* p, unsigned v) { return __hip_atomic_fetch_add(p, v, __ATOMIC_RELAXED, __HIP_MEMORY_SCOPE_AGENT); }
__device__ __forceinline__ unsigned xb_xcc_id() { return (unsigned)__builtin_amdgcn_s_getreg((3 << 11) | 20) & 0xFu; }
#define XB_SPIN(cond, bar) do { unsigned _sp = 0; while (cond) { __builtin_amdgcn_s_sleep(1); \
    if ((++_sp & 255u) == 0u) { if (xb_ld(&(bar)[XB_TMO])) break; if (_sp > XB_SPIN_CAP) { atomicAdd(&(bar)[XB_TMO], 1u); break; } } } } while (0)
struct XcdBarrier { unsigned* bar; unsigned x; volatile LAS unsigned* st; };
__device__ __forceinline__ XcdBarrier xcd_barrier_post(unsigned* bar, volatile LAS unsigned* st) {
    XcdBarrier b; b.bar = bar; b.x = xb_xcc_id(); b.st = st;
    if (threadIdx.x == 0) (void)xb_add(&bar[XB_XCNT(b.x)], 1u);
    return b;
}
__device__ __forceinline__ void xcd_barrier_complete(unsigned* bar, unsigned x, unsigned& nloc, unsigned& nx) {
    const unsigned G = gridDim.x * gridDim.y * gridDim.z;
    unsigned sum, cnt, mine, sp = 0u;
    for (;;) {
        sum = 0u; cnt = 0u; mine = 0u;
#pragma unroll
        for (unsigned j = 0; j < 16; ++j) { const unsigned c = xb_ld(&bar[XB_XCNT(j)]); sum += c; cnt += (c > 0u) ? 1u : 0u; mine = (j == x) ? c : mine; }
        if (sum == G) break;
        __builtin_amdgcn_s_sleep(1);
        if ((++sp & 255u) == 0u) { if (xb_ld(&bar[XB_TMO])) break; if (sp > XB_SPIN_CAP) { atomicAdd(&bar[XB_TMO], 1u); break; } }
    }
    nloc = mine > 0u ? mine : 1u; nx = cnt > 0u ? cnt : 1u;
}
__device__ __forceinline__ void xcd_barrier(const XcdBarrier& b) {
    asm volatile("s_waitcnt vmcnt(0)" ::: "memory");
    __syncthreads();
    if (threadIdx.x == 0) {
        unsigned* bar = b.bar;
        __builtin_amdgcn_s_waitcnt(0);
        unsigned nloc = b.st[0], nx = b.st[1];
        if (nloc == 0u) { xcd_barrier_complete(bar, b.x, nloc, nx); b.st[0] = nloc; b.st[1] = nx; }
        const unsigned old = xb_add(&bar[XB_XSUB(b.x)], 1u);
        const unsigned gen = old / nloc;
        if (old + 1u == (gen + 1u) * nloc) {
            __builtin_amdgcn_fence(__ATOMIC_RELEASE, "agent");
            asm volatile("s_waitcnt vmcnt(0)" ::: "memory");
            const unsigned og = xb_add(&bar[XB_TOP], 1u);
            const unsigned tg = og / nx;
            if (og + 1u == (tg + 1u) * nx) xb_add(&bar[XB_TOPGEN], 1u);
            else XB_SPIN(xb_ld(&bar[XB_TOPGEN]) == tg, bar);
            __builtin_amdgcn_fence(__ATOMIC_ACQUIRE, "agent");
            xb_add(&bar[XB_XGEN(b.x)], 1u);
            asm volatile("s_waitcnt vmcnt(0)" ::: "memory");
        } else {
            XB_SPIN(xb_ld(&bar[XB_XGEN(b.x)]) == gen, bar);
            __builtin_amdgcn_fence(__ATOMIC_ACQUIRE, "agent");
            asm volatile("s_waitcnt vmcnt(0)" ::: "memory");
        }
    }
    __syncthreads();
}

__device__ __forceinline__ float wave_sum(float v) {
#pragma unroll
    for (int o = 1; o < 64; o <<= 1) v += __shfl_xor(v, o);
    return v;
}
struct Frame {
    LAS unsigned char* lds;
    volatile LAS unsigned* MISC;
    gu32* ctl;
    unsigned char* ws;
    int tid, lane, wave, G, bid;
    const float *x, *c; const int* positions;
    const float *w_ada, *b_ada, *g_pre_mix, *g_post_mix, *g_pre_ffn, *g_post_ffn, *w_in;
    const float *cmp_pos_k, *cmp_k_w1, *cmp_k_w2, *cmp_pos_v, *cmp_v_w1, *cmp_v_w2, *pool_w, *pool_scale;
    const float *w_pool_up, *w_nsa_up, *w_out, *w_router, *router_bias, *w_exp_gate, *w_exp_up, *w_exp_down, *w_sh_gate, *w_sh_up, *w_sh_down;
    float* out;
};

__device__ __forceinline__ void transpose_item(const float* W, int ldw, int nvalid, bf16* WT, int ldt, int k0, int n0, int dst_row0, const float* scale, LAS float* scr, int lane) {
    const int nn = n0 + (lane & 31); const bool ok = nn < nvalid;
    const float sc = (scale && ok) ? scale[nn] : 1.0f;
    float v[32];
#pragma unroll
    for (int i = 0; i < 32; ++i) { const int kk = 2 * i + (lane >> 5); v[i] = ok ? W[(size_t)(k0 + kk) * ldw + nn] : 0.f; }
#pragma unroll
    for (int i = 0; i < 32; ++i) { const int kk = 2 * i + (lane >> 5); scr[kk * 33 + (lane & 31)] = v[i] * sc; }
    LDS_WAIT(); asm volatile("" ::: "memory");
    const int c = lane & 7;
#pragma unroll
    for (int j = 0; j < 4; ++j) { const int n = (lane >> 3) + 8 * j; const LAS float* s = scr + (8 * c) * 33 + n;
        v4u o; o.x = pk2(s[0 * 33], s[1 * 33]); o.y = pk2(s[2 * 33], s[3 * 33]); o.z = pk2(s[4 * 33], s[5 * 33]); o.w = pk2(s[6 * 33], s[7 * 33]);
        *(GAS v4u*)(WT + (size_t)(dst_row0 + n) * ldt + k0 + 8 * c) = o; }
    LDS_WAIT(); asm volatile("" ::: "memory");
}
__device__ __forceinline__ void tr_job(const float* W, int K, int N, int nvalid, bf16* WT, int it, LAS float* scr, int lane) {
    const int nblk = N / 32, kb = it / nblk, nb = it % nblk;
    transpose_item(W, nvalid, nvalid, WT, K, 64 * kb, 32 * nb, 32 * nb, nullptr, scr, lane);
}

template <bool SILU>
__device__ __forceinline__ void gemv64(Frame& F, const float* vec, const float* W, int ldw, int K, int col0, const float* addend, float* out) {
    LAS float* red = (LAS float*)(F.lds + RING_OFF);
    const int rsub = F.lane >> 4, c4 = F.lane & 15;
    const int kper = K / NWAVES, kbeg = F.wave * kper;
    f32x4 acc = (f32x4){0.f, 0.f, 0.f, 0.f};
#pragma unroll 8
    for (int k = kbeg + rsub; k < kbeg + kper; k += 4) {
        float v = vec[k]; if (SILU) v = v / (1.0f + __expf(-v));
        const f32x4 w = *(const GAS f32x4*)(W + (size_t)k * ldw + col0 + 4 * c4);
        acc += w * v;
    }
#pragma unroll
    for (int j = 0; j < 4; ++j) { acc[j] += __shfl_xor(acc[j], 16); acc[j] += __shfl_xor(acc[j], 32); }
    __syncthreads();
    if (rsub == 0) { red[F.wave * 64 + 4 * c4 + 0] = acc[0]; red[F.wave * 64 + 4 * c4 + 1] = acc[1]; red[F.wave * 64 + 4 * c4 + 2] = acc[2]; red[F.wave * 64 + 4 * c4 + 3] = acc[3]; }
    __syncthreads();
    if (F.tid < 64) { float s = addend ? addend[col0 + F.tid] : 0.f;
#pragma unroll
        for (int w = 0; w < NWAVES; ++w) s += red[w * 64 + F.tid];
        out[col0 + F.tid] = s; }
    __syncthreads();
}

__device__ __forceinline__ void p0_prologue(Frame& F) {
    unsigned char* ws = F.ws;
    float* small = (float*)(ws + WS_SMALL);
    if (F.bid < 192) gemv64<true>(F, F.c, F.w_ada, 6 * D, D, 64 * F.bid, F.b_ada, small + SM_MOD / 4);
    else if (F.bid < 198) gemv64<false>(F, F.cmp_pos_k, F.cmp_k_w1, 384, 3072, 64 * (F.bid - 192), nullptr, small + SM_BIASK / 4);
    else if (F.bid < 202) gemv64<false>(F, F.cmp_pos_v, F.cmp_v_w1, 256, 2048, 64 * (F.bid - 198), nullptr, small + SM_BIASV / 4);
    {
        const float inv[12] = {1.000000000e+00f, 3.350316475e-01f, 1.122462048e-01f, 3.760603093e-02f, 1.259921050e-02f, 4.221134251e-03f, 1.414213562e-03f, 4.738062997e-04f, 1.587401052e-04f, 5.318295897e-05f, 1.781797436e-05f, 5.969585306e-06f};
        float* rope = small + SM_ROPE / 4;
        const int gt = F.bid * 512 + F.tid, NT = F.G * 512;
        for (int idx = gt; idx < T * 12; idx += NT) {
            const int t = idx / 12, i = idx % 12;
            float iv = inv[0];
#pragma unroll
            for (int q = 1; q < 12; ++q) iv = (i == q) ? inv[q] : iv;
            const float ang = (float)F.positions[t] * iv;
            const float kf = rintf(ang * 0.15915494309189535f);
            float r = fmaf(-kf, 6.2831855f, ang); r = fmaf(-kf, -1.7484555e-07f, r);
            rope[t * 24 + i] = __cosf(r); rope[t * 24 + 12 + i] = __sinf(r);
        }
        bf16* wr_hi = (bf16*)(ws + WS_WRT); bf16* wr_lo = wr_hi + 64 * 2048;
        for (int idx = gt; idx < 64 * 2048; idx += NT) {
            const int e = idx & 63, d = idx >> 6;
            const float v = F.w_router[idx];
            const unsigned h = f2bf(v); const float lo = v - bf2f(h);
            wr_hi[e * 2048 + d] = (bf16)h; wr_lo[e * 2048 + d] = (bf16)f2bf(lo);
        }
    }
    LAS float* scr = (LAS float*)(F.lds + RING_OFF + 4096 + F.wave * 8704);
    const int gw = F.bid * NWAVES + F.wave, NGW = F.G * NWAVES;
    constexpr int I_IN = 32 * 272, I_POOL = 4 * 4 * 8, I_CK = 48 * 16, I_CV = 32 * 8, I_PU = 16 * 64, I_NU = 16 * 64, I_OUT = 32 * 64;
    constexpr int NITEMS = I_IN + I_POOL + I_CK + I_CV + I_PU + I_NU + I_OUT;
    for (int it = gw; it < NITEMS; it += NGW) {
        int r = it;
        if (r < I_IN) { tr_job(F.w_in, 2048, NP, IN_COLS, (bf16*)(ws + WS_WIN), r, scr, F.lane); continue; } r -= I_IN;
        if (r < I_POOL) { const int g = r / 32, q = r % 32, kb = q / 8, nb = q % 8;
            transpose_item(F.pool_w + (size_t)g * 65536, 256, 256, (bf16*)(ws + WS_WPOOL) + (size_t)g * 65536, 256, 64 * kb, 32 * nb, 32 * nb, F.pool_scale + g * 256, scr, F.lane); continue; } r -= I_POOL;
        if (r < I_CK) { tr_job(F.cmp_k_w1, 3072, 512, 384, (bf16*)(ws + WS_WCK), r, scr, F.lane); continue; } r -= I_CK;
        if (r < I_CV) { tr_job(F.cmp_v_w1, 2048, 256, 256, (bf16*)(ws + WS_WCV), r, scr, F.lane); continue; } r -= I_CV;
        if (r < I_PU) { tr_job(F.w_pool_up, 1024, 2048, 2048, (bf16*)(ws + WS_WPU), r, scr, F.lane); continue; } r -= I_PU;
        if (r < I_NU) { tr_job(F.w_nsa_up, 1024, 2048, 2048, (bf16*)(ws + WS_WNU), r, scr, F.lane); continue; } r -= I_NU;
        tr_job(F.w_out, 2048, 2048, 2048, (bf16*)(ws + WS_WOUT), r, scr, F.lane);
    }
}

constexpr int MOE_I_E1 = 32 * 16, MOE_I_E2 = 8 * 64;
constexpr int MOE_I_G = NE1 * MOE_I_E1, MOE_I_U = NE1 * MOE_I_E1, MOE_I_D = NE1 * MOE_I_E2;
constexpr int MOE_ITEMS = MOE_I_G + MOE_I_U + MOE_I_D, MOE_BATCH = 32, MOE_NBATCH = MOE_ITEMS / MOE_BATCH;
static_assert(MOE_ITEMS % MOE_BATCH == 0, "batches");
constexpr int CW_CONV = 4608;
__device__ __forceinline__ void moe_item(Frame& F, int r, LAS float* scr) {
    unsigned char* ws = F.ws;
    if (r < MOE_I_G + MOE_I_U) {
        const int s = r >= MOE_I_G ? 1 : 0; if (s) r -= MOE_I_G;
        const int e = r / MOE_I_E1, q = r % MOE_I_E1, kb = q / 16, nb = q % 16, n0 = 32 * nb;
        const float* src = (e < NE) ? ((s ? F.w_exp_up : F.w_exp_gate) + (size_t)e * 2048 * 512) : (s ? F.w_sh_up : F.w_sh_gate);
        transpose_item(src, 512, 512, (bf16*)(ws + WS_W1) + (size_t)e * 1024 * 2048, 2048, 64 * kb, n0, 256 * (n0 >> 7) + 128 * s + (n0 & 127), nullptr, scr, F.lane); return; }
    r -= MOE_I_G + MOE_I_U;
    { const int e = r / MOE_I_E2, q = r % MOE_I_E2, kb = q / 64, nb = q % 64;
      const float* src = (e < NE) ? (F.w_exp_down + (size_t)e * 512 * 2048) : F.w_sh_down;
      transpose_item(src, 2048, 2048, (bf16*)(ws + WS_W2) + (size_t)e * 2048 * 512, 512, 64 * kb, 32 * nb, 32 * nb, nullptr, scr, F.lane); }
}
__device__ __forceinline__ bool conv_pull(Frame& F, int max_batches) {
    LAS float* scr = (LAS float*)(F.lds + RING_OFF + 4096 + F.wave * 8704);
    volatile LAS unsigned* slot = F.MISC + 16;
    if (max_batches <= 0) return true;
    unsigned nxt = 0u;
    if (F.tid == 0) nxt = __hip_atomic_fetch_add((unsigned*)(F.ctl + CW_CONV), 1u, __ATOMIC_RELAXED, __HIP_MEMORY_SCOPE_AGENT);
    for (int n = 0; n < max_batches; ++n) {
        if (F.tid == 0) *slot = nxt;
        __syncthreads();
        const int b = (int)*slot;
        __syncthreads();
        if (b >= MOE_NBATCH) return false;
        if (F.tid == 0 && n + 1 < max_batches) nxt = __hip_atomic_fetch_add((unsigned*)(F.ctl + CW_CONV), 1u, __ATOMIC_RELAXED, __HIP_MEMORY_SCOPE_AGENT);
#pragma nounroll
        for (int q = 0; q < 4; ++q) moe_item(F, b * MOE_BATCH + 4 * F.wave + q, scr);
    }
    return true;
}
__device__ __forceinline__ void p1_norm(Frame& F) {
    const float* mod = (const float*)(F.ws + WS_SMALL + SM_MOD);
    bf16* H = (bf16*)(F.ws + WS_H);
    const int gw = F.bid * NWAVES + F.wave, NGW = F.G * NWAVES, lane = F.lane;
    for (int row = gw; row < T; row += 2 * NGW) {
        const int row2 = row + NGW; const bool two = row2 < T;
        const GAS f32x4* xa = (const GAS f32x4*)(F.x + (size_t)row * D) + lane;
        const GAS f32x4* xb = (const GAS f32x4*)(F.x + (size_t)(two ? row2 : row) * D) + lane;
        f32x4 va[8], vb[8];
#pragma unroll
        for (int j = 0; j < 8; ++j) { va[j] = xa[64 * j]; vb[j] = xb[64 * j]; }
        float sa = 0.f, sb = 0.f;
#pragma unroll
        for (int j = 0; j < 8; ++j) { sa += (va[j].x * va[j].x + va[j].y * va[j].y) + (va[j].z * va[j].z + va[j].w * va[j].w); sb += (vb[j].x * vb[j].x + vb[j].y * vb[j].y) + (vb[j].z * vb[j].z + vb[j].w * vb[j].w); }
        const float ra = 1.0f / sqrtf(wave_sum(sa) * (1.0f / D) + RMS_EPS), rb = 1.0f / sqrtf(wave_sum(sb) * (1.0f / D) + RMS_EPS);
        GAS v2u* oa = (GAS v2u*)(H + (size_t)row * D) + lane; GAS v2u* ob = (GAS v2u*)(H + (size_t)row2 * D) + lane;
#pragma unroll
        for (int j = 0; j < 8; ++j) {
            const int col = 4 * (lane + 64 * j);
            const f32x4 g = *(const GAS f32x4*)(F.g_pre_mix + col), sh = *(const GAS f32x4*)(mod + col), sc = *(const GAS f32x4*)(mod + D + col);
            const f32x4 gs = g * (sc + 1.0f);
            const f32x4 ha = (va[j] * ra) * gs + sh, hb = (vb[j] * rb) * gs + sh;
            v2u o; o.x = pk2(ha.x, ha.y); o.y = pk2(ha.z, ha.w); oa[64 * j] = o;
            if (two) { v2u p; p.x = pk2(hb.x, hb.y); p.y = pk2(hb.z, hb.w); ob[64 * j] = p; }
        }
    }
}

__device__ __forceinline__ void unpack8(const v4u w, float (&f)[8]) { f[0] = bflo(w.x); f[1] = bfhi(w.x); f[2] = bflo(w.y); f[3] = bfhi(w.y); f[4] = bflo(w.z); f[5] = bfhi(w.z); f[6] = bflo(w.w); f[7] = bfhi(w.w); }
__device__ __forceinline__ v4u pack8(const float (&f)[8]) { v4u o; o.x = pk2(f[0], f[1]); o.y = pk2(f[2], f[3]); o.z = pk2(f[4], f[5]); o.w = pk2(f[6], f[7]); return o; }

__device__ __forceinline__ void rope24(const bf16* src, bf16* dst, const float* cs, float scale) {
    float v[24];
    { float a[8]; unpack8(*(const GAS v4u*)(src), a);
#pragma unroll
      for (int i = 0; i < 8; ++i) v[i] = a[i];
      unpack8(*(const GAS v4u*)(src + 8), a);
#pragma unroll
      for (int i = 0; i < 8; ++i) v[8 + i] = a[i];
      unpack8(*(const GAS v4u*)(src + 16), a);
#pragma unroll
      for (int i = 0; i < 8; ++i) v[16 + i] = a[i]; }
    float o[24];
#pragma unroll
    for (int i = 0; i < 12; ++i) { const float c = cs[i], s = cs[12 + i]; o[i] = (v[i] * c - v[12 + i] * s) * scale; o[12 + i] = (v[12 + i] * c + v[i] * s) * scale; }
    float a[8];
#pragma unroll
    for (int i = 0; i < 8; ++i) a[i] = o[i];
    *(GAS v4u*)(dst) = pack8(a);
#pragma unroll
    for (int i = 0; i < 8; ++i) a[i] = o[8 + i];
    *(GAS v4u*)(dst + 8) = pack8(a);
#pragma unroll
    for (int i = 0; i < 8; ++i) a[i] = o[16 + i];
    *(GAS v4u*)(dst + 16) = pack8(a);
}
template <bool ROPE>
__device__ __forceinline__ void seg96(const bf16* src, int nheads, bf16* dbase, size_t hstride, const float* cs, float scale, int lane) {
    const int nch = nheads * 12;
    for (int ci = lane; ci < nch; ci += 64) {
        const int head = ci / 12, kk = ci % 12;
        if (ROPE && kk < 3) continue;
        float a[8]; unpack8(*(const GAS v4u*)(src + ci * 8), a);
#pragma unroll
        for (int i = 0; i < 8; ++i) a[i] *= scale;
        *(GAS v4u*)(dbase + (size_t)head * hstride + kk * 8) = pack8(a);
    }
    if (ROPE && lane < nheads) rope24(src + lane * 96, dbase + (size_t)lane * hstride, cs, scale);
}

__device__ __forceinline__ void rope24_regs(const v4u c0, const v4u c1, const v4u c2, bf16* dst, const float (&cs)[24], float scale) {
    float v[24];
    { float a[8]; unpack8(c0, a);
#pragma unroll
      for (int i = 0; i < 8; ++i) v[i] = a[i];
      unpack8(c1, a);
#pragma unroll
      for (int i = 0; i < 8; ++i) v[8 + i] = a[i];
      unpack8(c2, a);
#pragma unroll
      for (int i = 0; i < 8; ++i) v[16 + i] = a[i]; }
    float o[24];
#pragma unroll
    for (int i = 0; i < 12; ++i) { const float c = cs[i], s = cs[12 + i]; o[i] = (v[i] * c - v[12 + i] * s) * scale; o[12 + i] = (v[12 + i] * c + v[i] * s) * scale; }
    float a[8];
#pragma unroll
    for (int i = 0; i < 8; ++i) a[i] = o[i];
    *(GAS v4u*)(dst) = pack8(a);
#pragma unroll
    for (int i = 0; i < 8; ++i) a[i] = o[8 + i];
    *(GAS v4u*)(dst + 8) = pack8(a);
#pragma unroll
    for (int i = 0; i < 8; ++i) a[i] = o[16 + i];
    *(GAS v4u*)(dst + 16) = pack8(a);
}
__device__ __forceinline__ v4u scale8(const v4u w, float scale) { float a[8]; unpack8(w, a);
#pragma unroll
    for (int i = 0; i < 8; ++i) a[i] *= scale;
    return pack8(a); }

__device__ __forceinline__ void p3_relayout(Frame& F, int vb, int nvb) {
    unsigned char* ws = F.ws;
    const bf16* PROJ = (const bf16*)(ws + WS_PROJ);
    const float* rope = (const float*)(ws + WS_SMALL + SM_ROPE);
    bf16* QR = (bf16*)(ws + WS_QR); bf16* KSG = (bf16*)(ws + WS_KSG); bf16* KWG = (bf16*)(ws + WS_KWG); bf16* KCG = (bf16*)(ws + WS_KCG); bf16* VCG = (bf16*)(ws + WS_VCG);
    bf16* VST = (bf16*)(ws + WS_VST); bf16* VWT = (bf16*)(ws + WS_VWT); bf16* DPOOL = (bf16*)(ws + WS_DPOOL);
    const int gw = vb * NWAVES + F.wave, NGW = nvb * NWAVES, lane = F.lane;
    LAS float* nrm = (LAS float*)(F.lds + RING_OFF + 73728 + F.wave * 512);
    float ksmax = 0.f, kwmax = 0.f;
    for (int t = gw; t < T; t += NGW) {
        const bf16* pr = PROJ + (size_t)t * NP;
        const float* csp = rope + t * 24;
        v4u qc[3];
#pragma unroll
        for (int i = 0; i < 3; ++i) qc[i] = *(const GAS v4u*)(pr + C_Q + (lane + 64 * i) * 8);
        const int l48 = lane < 48 ? lane : 47, l32 = lane & 31;
        const v4u ksc = *(const GAS v4u*)(pr + C_KS + l48 * 8), kwc = *(const GAS v4u*)(pr + C_KW + l48 * 8), kcc = *(const GAS v4u*)(pr + C_KC + l48 * 8), vcc = *(const GAS v4u*)(pr + C_VC + l32 * 8);
        v4u rq[3], rs[3], rw[3];
#pragma unroll
        for (int i = 0; i < 3; ++i) { rq[i] = *(const GAS v4u*)(pr + C_Q + (lane & 15) * DQK + 8 * i); rs[i] = *(const GAS v4u*)(pr + C_KS + (lane & 3) * DQK + 8 * i); rw[i] = *(const GAS v4u*)(pr + C_KW + (lane & 3) * DQK + 8 * i); }
        float cs[24];
#pragma unroll
        for (int i = 0; i < 24; ++i) cs[i] = csp[i];
        { float a[8], ss = 0.f, sw = 0.f; unpack8(ksc, a);
#pragma unroll
          for (int i = 0; i < 8; ++i) ss += a[i] * a[i];
          unpack8(kwc, a);
#pragma unroll
          for (int i = 0; i < 8; ++i) sw += a[i] * a[i];
          if (lane < 48) { nrm[lane] = ss; nrm[48 + lane] = sw; }
          LDS_WAIT(); asm volatile("" ::: "memory");
          if (lane < NG) { float s = 0.f, w2 = 0.f;
#pragma unroll
              for (int i = 0; i < 12; ++i) { s += nrm[12 * lane + i]; w2 += nrm[48 + 12 * lane + i]; }
              ksmax = fmaxf(ksmax, s); kwmax = fmaxf(kwmax, w2); }
          LDS_WAIT(); asm volatile("" ::: "memory"); }
        {
            const int ci = lane, g = ci >> 5, win = 2 << g, cnt = (t + 1 < win) ? (t + 1) : win;
            v4u w[4];
#pragma unroll
            for (int r = 0; r < 4; ++r) w[r] = (r < cnt) ? *(const GAS v4u*)(pr - (size_t)r * NP + C_U + ci * 8) : (v4u){0u, 0u, 0u, 0u};
            float s[8], u[8]; unpack8(w[0], u);
#pragma unroll
            for (int i = 0; i < 8; ++i) s[i] = u[i];
#pragma unroll
            for (int r = 1; r < 4; ++r) { float a[8]; unpack8(w[r], a);
#pragma unroll
                for (int i = 0; i < 8; ++i) s[i] += a[i]; }
            const float ic = 1.0f / (float)cnt;
#pragma unroll
            for (int i = 0; i < 8; ++i) s[i] = s[i] * ic - u[i];
            *(GAS v4u*)(DPOOL + (size_t)t * 1024 + ci * 8) = pack8(s);
        }
        {
            const int ci = 64 + lane, g = ci >> 5, win = 2 << g, cnt = (t + 1 < win) ? (t + 1) : win;
            v4u w[16];
#pragma unroll
            for (int r = 0; r < 16; ++r) w[r] = (r < cnt) ? *(const GAS v4u*)(pr - (size_t)r * NP + C_U + ci * 8) : (v4u){0u, 0u, 0u, 0u};
            float s[8], u[8]; unpack8(w[0], u);
#pragma unroll
            for (int i = 0; i < 8; ++i) s[i] = u[i];
#pragma unroll
            for (int r = 1; r < 16; ++r) { float a[8]; unpack8(w[r], a);
#pragma unroll
                for (int i = 0; i < 8; ++i) s[i] += a[i]; }
            const float ic = 1.0f / (float)cnt;
#pragma unroll
            for (int i = 0; i < 8; ++i) s[i] = s[i] * ic - u[i];
            *(GAS v4u*)(DPOOL + (size_t)t * 1024 + ci * 8) = pack8(s);
        }
        constexpr float QS = 0.14724444236568886f;
#pragma unroll
        for (int i = 0; i < 3; ++i) { const int ci = lane + 64 * i, head = ci / 12, kk = ci % 12;
            if (kk >= 3) *(GAS v4u*)(QR + (size_t)t * (NH * DQK) + head * DQK + kk * 8) = scale8(qc[i], QS); }
        if (lane < NH) rope24_regs(rq[0], rq[1], rq[2], QR + (size_t)t * (NH * DQK) + lane * DQK, cs, QS);
        if (lane < 48) { const int g = lane / 12, kk = lane % 12;
            if (kk >= 3) { *(GAS v4u*)(KSG + ((size_t)g * T + t) * DQK + kk * 8) = ksc; *(GAS v4u*)(KWG + ((size_t)g * T + t) * DQK + kk * 8) = kwc; }
            *(GAS v4u*)(KCG + ((size_t)g * T + t) * DQK + kk * 8) = kcc; }
        if (lane < NG) { rope24_regs(rs[0], rs[1], rs[2], KSG + ((size_t)lane * T + t) * DQK, cs, 1.0f); rope24_regs(rw[0], rw[1], rw[2], KWG + ((size_t)lane * T + t) * DQK, cs, 1.0f); }
        if (lane < 32) { const int g = lane >> 3, kk = lane & 7; *(GAS v4u*)(VCG + ((size_t)g * T + t) * DV + kk * 8) = vcc; }
    }
    { LAS float* bm = (LAS float*)(F.lds + RING_OFF + 73728 + 4096);
      if (lane < NG) { bm[F.wave * 8 + lane] = ksmax; bm[F.wave * 8 + 4 + lane] = kwmax; }
      __syncthreads();
      if (F.tid < 8) { float v = 0.f;
#pragma unroll
          for (int w = 0; w < NWAVES; ++w) v = fmaxf(v, bm[w * 8 + F.tid]);
          float* dst = (float*)(ws + WS_SMALL + (F.tid < 4 ? SM_KNS : SM_KNW)); dst[(F.tid & 3) * 256 + vb] = v; }
      __syncthreads(); }
    LAS bf16* tl = (LAS bf16*)(F.lds + RING_OFF + F.wave * 9216);
    for (int it = gw; it < 2 * NG * (T / 64); it += NGW) {
        const int tens = it / (NG * (T / 64)), rem = it % (NG * (T / 64)), g = rem / (T / 64), tt = rem % (T / 64);
        const bf16* src = PROJ + (size_t)(tt * 64 + lane) * NP + (tens ? C_VW : C_VS) + g * DV;
        bf16* dst = (tens ? VWT : VST) + ((size_t)g * DV) * T + tt * 64;
#pragma unroll
        for (int c = 0; c < 8; ++c) { const v4u w = *(const GAS v4u*)(src + c * 8);
            const unsigned ww[4] = {w.x, w.y, w.z, w.w};
#pragma unroll
            for (int q = 0; q < 4; ++q) { tl[(c * 8 + 2 * q) * 72 + lane] = (bf16)(ww[q] & 0xffffu); tl[(c * 8 + 2 * q + 1) * 72 + lane] = (bf16)(ww[q] >> 16); } }
        LDS_WAIT(); asm volatile("" ::: "memory");
#pragma unroll
        for (int c = 0; c < 8; ++c) { const v4u w = *(const LAS v4u*)(tl + lane * 72 + c * 8); *(GAS v4u*)(dst + (size_t)lane * T + c * 8) = w; }
        LDS_WAIT(); asm volatile("" ::: "memory");
    }
}
struct SchedPlain {
    int nM, nN, G, c; const char* Bt; unsigned lda2; size_t ldb2;
    __device__ __forceinline__ bool next(int i, pg8::Unit& u) const { u.aux = 0; return pg8::static_tile(i, G, c, nM, nN, u.pm, u.pn); }
    __device__ __forceinline__ unsigned aoff(const pg8::Unit& u, int r) const { return (unsigned)(u.pm * 256 + r) * lda2; }
    __device__ __forceinline__ const char* bptr(const pg8::Unit& u) const { return Bt + (size_t)u.pn * 256 * ldb2; }
};
struct SchedInTail {
    int c; const char* Bt; unsigned lda2; size_t ldb2;
    __device__ __forceinline__ bool next(int i, pg8::Unit& u) const { if (i != 0 || c < 0 || c >= 64) return false; u.pm = c >> 1; u.pn = 32 + (c & 1); u.aux = 0; return true; }
    __device__ __forceinline__ unsigned aoff(const pg8::Unit& u, int r) const { return (unsigned)(u.pm * 256 + r) * lda2; }
    __device__ __forceinline__ const char* bptr(const pg8::Unit& u) const { return Bt + (size_t)u.pn * 256 * ldb2; }
};
struct SchedPool {
    int G, c; const char* Bt;
    __device__ __forceinline__ bool next(int i, pg8::Unit& u) const { const int L = i * G + c; if (L >= 128) return false; u.pm = L >> 2; u.pn = 0; u.aux = L & 3; return true; }
    __device__ __forceinline__ unsigned aoff(const pg8::Unit& u, int r) const { return (unsigned)(u.pm * 256 + r) * 2048u + (unsigned)u.aux * 512u; }
    __device__ __forceinline__ const char* bptr(const pg8::Unit& u) const { return Bt + (size_t)u.aux * 65536 * 2; }
};
struct SchedSplitK {
    int nN, G, c; const char* Bt; unsigned lda2; size_t ldb2; int kslice;
    __device__ __forceinline__ bool next(int i, pg8::Unit& u) const { const int L = i * G + c; if (L < 0 || L >= 8 * nN * 4) return false; u.aux = L & 3; const int q = L >> 2; u.pn = q % nN; u.pm = q / nN; return true; }
    __device__ __forceinline__ unsigned aoff(const pg8::Unit& u, int r) const { return (unsigned)(u.pm * 256 + r) * lda2 + (unsigned)(u.aux * kslice) * 2u; }
    __device__ __forceinline__ const char* bptr(const pg8::Unit& u) const { return Bt + (size_t)u.pn * 256 * ldb2 + (size_t)u.aux * kslice * 2; }
};
struct SchedMoe1 {
    int G, c, ntiles; const LAS int* tile_e; const int* tok; const char* W1;
    __device__ __forceinline__ bool next(int i, pg8::Unit& u) const { const int L = i * G + c; if (L >= ntiles * 4) return false; u.pm = L >> 2; u.pn = L & 3; u.aux = tile_e[u.pm]; return true; }
    __device__ __forceinline__ unsigned aoff(const pg8::Unit& u, int r) const { return (unsigned)tok[u.pm * 256 + r] * 4096u; }
    __device__ __forceinline__ const char* bptr(const pg8::Unit& u) const { return W1 + ((size_t)u.aux * 1024 + (size_t)u.pn * 256) * 4096; }
};
struct SchedMoe2 {
    int G, c, ntiles; const LAS int* tile_e; const char* W2;
    __device__ __forceinline__ bool next(int i, pg8::Unit& u) const { const int L = i * G + c; if (L >= ntiles * 8) return false; u.pm = L >> 3; u.pn = L & 7; u.aux = tile_e[u.pm]; return true; }
    __device__ __forceinline__ unsigned aoff(const pg8::Unit& u, int r) const { return (unsigned)(u.pm * 256 + r) * 1024u; }
    __device__ __forceinline__ const char* bptr(const pg8::Unit& u) const { return W2 + ((size_t)u.aux * 2048 + (size_t)u.pn * 256) * 1024; }
};

using pg8::f32x4; using pg8::u32x4;
#define EPI_ARGS const f32x4 (&acc)[2][2][4][2], const pg8::Unit& u, int wr, int wc, int fr, int fq
struct EpiBf16 {
    static constexpr bool PERM = true;
    bf16* O; int ldc; int cbase; int caux;
    __device__ __forceinline__ void operator()(EPI_ARGS) const {
        const int row0 = u.pm * 256 + wr * 64 + fr, col0 = cbase + caux * u.aux + u.pn * 256 + wc * 32 + 8 * fq;
#pragma unroll
        for (int ai = 0; ai < 2; ++ai)
#pragma unroll
            for (int m = 0; m < 4; ++m) { bf16* rowp = O + (size_t)(row0 + ai * 128 + m * 16) * ldc + col0;
#pragma unroll
                for (int bj = 0; bj < 2; ++bj) { const f32x4 v0 = acc[ai][bj][m][0], v1 = acc[ai][bj][m][1];
                    u32x4 w; w.x = pg8::cvt_pk_bf16(v0[0], v0[1]); w.y = pg8::cvt_pk_bf16(v0[2], v0[3]); w.z = pg8::cvt_pk_bf16(v1[0], v1[1]); w.w = pg8::cvt_pk_bf16(v1[2], v1[3]);
                    *(u32x4*)(rowp + bj * 128) = w; } }
    }
};
struct EpiF32 {
    static constexpr bool PERM = false;
    float* C; int ldc; size_t astride;
    __device__ __forceinline__ void operator()(EPI_ARGS) const {
        const int row0 = u.pm * 256 + wr * 64 + fr, col0 = u.pn * 256 + wc * 32 + 4 * fq;
        float* base = C + (size_t)u.aux * astride;
#pragma unroll
        for (int ai = 0; ai < 2; ++ai)
#pragma unroll
            for (int m = 0; m < 4; ++m) { float* rowp = base + (size_t)(row0 + ai * 128 + m * 16) * ldc + col0;
#pragma unroll
                for (int bj = 0; bj < 2; ++bj)
#pragma unroll
                    for (int n = 0; n < 2; ++n) *(f32x4*)(rowp + bj * 128 + n * 16) = acc[ai][bj][m][n]; }
    }
};
__device__ __forceinline__ void sig8(const u32x4 w, float (&s)[8]) {
    s[0] = sigmoidf_(bflo(w.x)); s[1] = sigmoidf_(bfhi(w.x)); s[2] = sigmoidf_(bflo(w.y)); s[3] = sigmoidf_(bfhi(w.y));
    s[4] = sigmoidf_(bflo(w.z)); s[5] = sigmoidf_(bfhi(w.z)); s[6] = sigmoidf_(bflo(w.w)); s[7] = sigmoidf_(bfhi(w.w));
}
template <bool ADD>
struct EpiGate {
    static constexpr bool PERM = true;
    bf16* O; const bf16* prev; const bf16* GM; int gcol;
    __device__ __forceinline__ void operator()(EPI_ARGS) const {
        const int row0 = u.pm * 256 + wr * 64 + fr, col0 = u.pn * 256 + wc * 32 + 8 * fq;
#pragma unroll
        for (int ai = 0; ai < 2; ++ai)
#pragma unroll
            for (int m = 0; m < 4; ++m) { const size_t row = (size_t)(row0 + ai * 128 + m * 16);
#pragma unroll
                for (int bj = 0; bj < 2; ++bj) { const int col = col0 + bj * 128;
                    float s[8]; sig8(*(const u32x4*)(GM + row * NP + gcol + col), s);
                    const f32x4 v0 = acc[ai][bj][m][0], v1 = acc[ai][bj][m][1];
                    float r[8] = {v0[0] * s[0], v0[1] * s[1], v0[2] * s[2], v0[3] * s[3], v1[0] * s[4], v1[1] * s[5], v1[2] * s[6], v1[3] * s[7]};
                    if (ADD) { const u32x4 p = *(const u32x4*)(prev + row * 2048 + col);
                        r[0] += bflo(p.x); r[1] += bfhi(p.x); r[2] += bflo(p.y); r[3] += bfhi(p.y); r[4] += bflo(p.z); r[5] += bfhi(p.z); r[6] += bflo(p.w); r[7] += bfhi(p.w); }
                    u32x4 w; w.x = pg8::cvt_pk_bf16(r[0], r[1]); w.y = pg8::cvt_pk_bf16(r[2], r[3]); w.z = pg8::cvt_pk_bf16(r[4], r[5]); w.w = pg8::cvt_pk_bf16(r[6], r[7]);
                    *(u32x4*)(O + row * 2048 + col) = w; } }
    }
};
struct EpiMoe1 {
    static constexpr bool PERM = true;
    bf16* HID; const float* wrow;
    __device__ __forceinline__ void operator()(EPI_ARGS) const {
        const int row0 = u.pm * 256 + wr * 64 + fr, col0 = u.pn * 128 + wc * 32 + 8 * fq;
        float wv[2][4];
#pragma unroll
        for (int ai = 0; ai < 2; ++ai)
#pragma unroll
            for (int m = 0; m < 4; ++m) wv[ai][m] = wrow[row0 + ai * 128 + m * 16];
#pragma unroll
        for (int ai = 0; ai < 2; ++ai)
#pragma unroll
            for (int m = 0; m < 4; ++m) { const size_t row = (size_t)(row0 + ai * 128 + m * 16);
                float r[8];
#pragma unroll
                for (int n = 0; n < 2; ++n)
#pragma unroll
                    for (int j = 0; j < 4; ++j) { const float gt = acc[ai][0][m][n][j], up = acc[ai][1][m][n][j]; r[4 * n + j] = gt / (1.0f + __expf(-gt)) * up * wv[ai][m]; }
                u32x4 w; w.x = pg8::cvt_pk_bf16(r[0], r[1]); w.y = pg8::cvt_pk_bf16(r[2], r[3]); w.z = pg8::cvt_pk_bf16(r[4], r[5]); w.w = pg8::cvt_pk_bf16(r[6], r[7]);
                *(u32x4*)(HID + row * 512 + col0) = w; }
    }
};
struct EpiMoe2 {
    static constexpr bool PERM = true;
    bf16* YB; const float* wrow;
    __device__ __forceinline__ void operator()(EPI_ARGS) const {
        const int row0 = u.pm * 256 + wr * 64 + fr, col0 = u.pn * 256 + wc * 32 + 8 * fq;
#pragma unroll
        for (int ai = 0; ai < 2; ++ai)
#pragma unroll
            for (int m = 0; m < 4; ++m) { const size_t row = (size_t)(row0 + ai * 128 + m * 16); const float ws_ = wrow[row];
#pragma unroll
                for (int bj = 0; bj < 2; ++bj) { const f32x4 v0 = acc[ai][bj][m][0] * ws_, v1 = acc[ai][bj][m][1] * ws_;
                    u32x4 w; w.x = pg8::cvt_pk_bf16(v0[0], v0[1]); w.y = pg8::cvt_pk_bf16(v0[2], v0[3]); w.z = pg8::cvt_pk_bf16(v1[0], v1[1]); w.w = pg8::cvt_pk_bf16(v1[2], v1[3]);
                    *(u32x4*)(YB + row * 2048 + col0 + bj * 128) = w; } }
    }
};
__device__ __forceinline__ void p5_cmp2(Frame& F) {
    unsigned char* ws = F.ws;
    const float* PARTK = (const float*)(ws + WS_PARTK); const float* PARTV = (const float*)(ws + WS_PARTV);
    const float* biask = (const float*)(ws + WS_SMALL + SM_BIASK); const float* biasv = (const float*)(ws + WS_SMALL + SM_BIASV);
    const float* rope = (const float*)(ws + WS_SMALL + SM_ROPE);
    bf16* KCR = (bf16*)(ws + WS_KCR); bf16* VCT = (bf16*)(ws + WS_VCT);
    LAS bf16* w2k = (LAS bf16*)(F.lds + RING_OFF); LAS bf16* w2v = (LAS bf16*)(F.lds + RING_OFF + 73728);
    LAS float* hid = (LAS float*)(F.lds + RING_OFF + 106496 + F.wave * 3072);
    LAS float* ovp = hid + 384;
    const int gw = F.bid * NWAVES + F.wave, NGW = F.G * NWAVES, lane = F.lane, tid = F.tid;
    if (F.bid * NWAVES >= NG * NCMPP) return;
    { f32x4 wk[18], wv[8];
#pragma unroll
      for (int i = 0; i < 18; ++i) wk[i] = *(const GAS f32x4*)(F.cmp_k_w2 + 4 * (tid + 512 * i));
#pragma unroll
      for (int i = 0; i < 8; ++i) wv[i] = *(const GAS f32x4*)(F.cmp_v_w2 + 4 * (tid + 512 * i));
#pragma unroll
      for (int i = 0; i < 18; ++i) { v2u o; o.x = pk2(wk[i].x, wk[i].y); o.y = pk2(wk[i].z, wk[i].w); *(LAS v2u*)(w2k + 4 * (tid + 512 * i)) = o; }
#pragma unroll
      for (int i = 0; i < 8; ++i) { v2u o; o.x = pk2(wv[i].x, wv[i].y); o.y = pk2(wv[i].z, wv[i].w); *(LAS v2u*)(w2v + 4 * (tid + 512 * i)) = o; } }
    __syncthreads();
    for (int row = gw; row < NG * NCMPP; row += NGW) {
        const int g = row >> 9, n = row & 511;
        if (n == NCMP) {
            for (int j = lane; j < DQK; j += 64) KCR[(size_t)row * DQK + j] = 0;
            VCT[((size_t)g * DV + lane) * NCMPP + n] = 0;
            if (lane == 0) ((float*)(ws + WS_SMALL + SM_KNC))[row] = 0.f;
            continue;
        }
        float sk[6], sv[4];
#pragma unroll
        for (int i = 0; i < 6; ++i) { const int c = lane + 64 * i; sk[i] = biask[c];
#pragma unroll
            for (int ks = 0; ks < 4; ++ks) sk[i] += PARTK[((size_t)ks * 2048 + row) * 512 + c]; }
#pragma unroll
        for (int i = 0; i < 4; ++i) { const int c = lane + 64 * i; sv[i] = biasv[c];
#pragma unroll
            for (int ks = 0; ks < 4; ++ks) sv[i] += PARTV[((size_t)ks * 2048 + row) * 256 + c]; }
#pragma unroll
        for (int i = 0; i < 6; ++i) hid[lane + 64 * i] = sk[i] / (1.0f + __expf(-sk[i]));
        LDS_WAIT(); asm volatile("" ::: "memory");
        { const int kq = lane / 24, c4 = lane % 24; f32x4 a = (f32x4){0.f, 0.f, 0.f, 0.f};
          if (lane < 48) { const LAS bf16* wp = w2k + (192 * kq) * DQK + 4 * c4; const LAS float* hp = hid + 192 * kq;
#pragma unroll 16
              for (int c = 0; c < 192; ++c) { const v2u w = *(const LAS v2u*)(wp + c * DQK); const float hv = hp[c]; a.x += bflo(w.x) * hv; a.y += bfhi(w.x) * hv; a.z += bflo(w.y) * hv; a.w += bfhi(w.y) * hv; }
              ovp[kq * 96 + 4 * c4 + 0] = a.x; ovp[kq * 96 + 4 * c4 + 1] = a.y; ovp[kq * 96 + 4 * c4 + 2] = a.z; ovp[kq * 96 + 4 * c4 + 3] = a.w; } }
        LDS_WAIT(); asm volatile("" ::: "memory");
        { const float* cs = rope + (16 * n + 31) * 24;
          for (int j = lane; j < DQK; j += 64) { float v = ovp[j] + ovp[96 + j];
              if (j < HALFROT) v = v * cs[j] - (ovp[j + HALFROT] + ovp[96 + j + HALFROT]) * cs[HALFROT + j];
              else if (j < ROT) v = v * cs[j - HALFROT] + (ovp[j - HALFROT] + ovp[96 + j - HALFROT]) * cs[j];
              KCR[(size_t)row * DQK + j] = (bf16)f2bf(v); } }
        { float q2 = 0.f;
          for (int j = lane; j < DQK; j += 64) { const float v = ovp[j] + ovp[96 + j]; q2 += v * v; }
          q2 = wave_sum(q2);
          if (lane == 0) ((float*)(ws + WS_SMALL + SM_KNC))[row] = q2; }
        LDS_WAIT(); asm volatile("" ::: "memory");
#pragma unroll
        for (int i = 0; i < 4; ++i) hid[lane + 64 * i] = sv[i] / (1.0f + __expf(-sv[i]));
        LDS_WAIT(); asm volatile("" ::: "memory");
        { const int kq = lane >> 4, c4 = lane & 15; f32x4 a = (f32x4){0.f, 0.f, 0.f, 0.f};
          const LAS bf16* wp = w2v + (64 * kq) * DV + 4 * c4; const LAS float* hp = hid + 64 * kq;
#pragma unroll 16
          for (int c = 0; c < 64; ++c) { const v2u w = *(const LAS v2u*)(wp + c * DV); const float hv = hp[c]; a.x += bflo(w.x) * hv; a.y += bfhi(w.x) * hv; a.z += bflo(w.y) * hv; a.w += bfhi(w.y) * hv; }
          ovp[kq * 64 + 4 * c4 + 0] = a.x; ovp[kq * 64 + 4 * c4 + 1] = a.y; ovp[kq * 64 + 4 * c4 + 2] = a.z; ovp[kq * 64 + 4 * c4 + 3] = a.w; }
        LDS_WAIT(); asm volatile("" ::: "memory");
        VCT[((size_t)g * DV + lane) * NCMPP + n] = (bf16)f2bf((ovp[lane] + ovp[64 + lane]) + (ovp[128 + lane] + ovp[192 + lane]));
        LDS_WAIT(); asm volatile("" ::: "memory");
    }
}

namespace nsa {
typedef __bf16 bf16x2_t __attribute__((ext_vector_type(2)));
typedef float f32x2_t __attribute__((ext_vector_type(2)));
constexpr int NST = 4, ST_K = 12288, ST_V = 8192, ST_BYTES = ST_K + ST_V;
constexpr int L_KV = 0, L_IMP = NST * ST_BYTES, IMP_PITCH = 129, L_SEL = L_IMP + 64 * IMP_PITCH * 4, L_END = L_SEL + 64 * 8 * 2;
static_assert(L_END <= RING_BYTES, "attention LDS");
constexpr float NEGBIG = -1e30f;
__device__ __forceinline__ unsigned cvtpk(float lo, float hi) { f32x2_t v = {lo, hi}; bf16x2_t b = __builtin_convertvector(v, bf16x2_t); return __builtin_bit_cast(unsigned, b); }
__device__ __forceinline__ int crow(int i, int h) { return (i & 3) + 8 * (i >> 2) + 4 * h; }
#define MFMA32(a, b, c) __builtin_amdgcn_mfma_f32_32x32x16_bf16((a), (b), (c), 0, 0, 0)
#define NSA_WAIT_V(n) asm volatile("s_waitcnt vmcnt(" #n ")" ::: "memory")

struct DmaOff { unsigned o0, o1, o2; };
__device__ __forceinline__ unsigned dma_src(int ii, int lane, int vlen) {
    if (ii < 12) { const int q = 64 * ii + lane, p = q >> 8, qq = q & 255, row = qq >> 2, c = (qq & 3) ^ ((row >> 2) & 3); return (unsigned)(row * DQK + (4 * p + c) * 8); }
    const int q = 64 * (ii - 12) + lane, dv = q >> 3, cv = (q & 7) ^ ((dv >> 1) & 7); return (unsigned)(dv * vlen + cv * 8);
}
template <bool WITH_V>
__device__ __forceinline__ void tile_dma(LAS unsigned char* stage, const bf16* ksrc, const bf16* vsrc, const DmaOff& D, int w) {
    __builtin_amdgcn_global_load_lds((const unsigned*)(ksrc + D.o0), (LAS unsigned*)(stage + w * 1024), 16, 0, 0);
    if (w < 4) __builtin_amdgcn_global_load_lds((const unsigned*)(ksrc + D.o1), (LAS unsigned*)(stage + (w + 8) * 1024), 16, 0, 0);
    if (WITH_V) {
        if (w >= 4) __builtin_amdgcn_global_load_lds((const unsigned*)(vsrc + D.o1), (LAS unsigned*)(stage + (w + 8) * 1024), 16, 0, 0);
        else __builtin_amdgcn_global_load_lds((const unsigned*)(vsrc + D.o2), (LAS unsigned*)(stage + (w + 16) * 1024), 16, 0, 0);
    }
}

typedef float f32x2v __attribute__((ext_vector_type(2)));
__device__ __forceinline__ float quad_sum(float v) {
    v += __builtin_bit_cast(float, __builtin_amdgcn_update_dpp(0, __builtin_bit_cast(int, v), 0xB1, 0xf, 0xf, false));
    v += __builtin_bit_cast(float, __builtin_amdgcn_update_dpp(0, __builtin_bit_cast(int, v), 0x4E, 0xf, 0xf, false));
    return v; }
__device__ __forceinline__ float xhalf_max(float v) { const auto r = __builtin_amdgcn_permlane32_swap(__builtin_bit_cast(unsigned, v), __builtin_bit_cast(unsigned, v), false, false);
    return __builtin_fmaxf(__builtin_bit_cast(float, r[0]), __builtin_bit_cast(float, r[1])); }
__device__ __forceinline__ float xhalf_sum(float v) { const auto r = __builtin_amdgcn_permlane32_swap(__builtin_bit_cast(unsigned, v), __builtin_bit_cast(unsigned, v), false, false);
    return __builtin_bit_cast(float, r[0]) + __builtin_bit_cast(float, r[1]); }

template <int MODE, bool MASKED>
__device__ __forceinline__ void subtile(const LAS unsigned char* st, LAS float* IMP, int sub, int key0,
                                        const bf16x8 (&qf)[6], int t, int tok_l, int head, int r, int h, unsigned selbit,
                                        float& m, float& l, float linv, f32x16 (&O)[2]) {
    f32x16 x;
#pragma unroll
    for (int i = 0; i < 16; ++i) x[i] = 0.f;
    const unsigned kb0 = (unsigned)(size_t)st + 64u * (unsigned)r + ((unsigned)((h ^ (r >> 2)) & 3) << 4) + (unsigned)(sub * 2048);
    bf16x8 kf[6];
#pragma unroll
    for (int s = 0; s < 6; ++s) kf[s] = *(const LAS bf16x8*)(size_t)((kb0 ^ ((unsigned)(s & 1) << 5)) + (unsigned)((s >> 1) * 4096));
    v4u vf[2][2];
    { const unsigned vb = (unsigned)(size_t)st + (unsigned)ST_K + 128u * (unsigned)r + 8u * (unsigned)h + ((unsigned)((r >> 1) & 7) << 4);
#pragma unroll
      for (int s = 0; s < 2; ++s)
#pragma unroll
          for (int dvt = 0; dvt < 2; ++dvt) { const unsigned cv = (unsigned)(4 * sub + 2 * s);
              const v2u lo = *(const LAS v2u*)(size_t)((vb ^ (cv << 4)) + (unsigned)(dvt * 4096)), hi = *(const LAS v2u*)(size_t)((vb ^ ((cv + 1u) << 4)) + (unsigned)(dvt * 4096));
              vf[s][dvt].x = lo.x; vf[s][dvt].y = lo.y; vf[s][dvt].z = hi.x; vf[s][dvt].w = hi.y; } }
#pragma unroll
    for (int s = 0; s < 6; ++s) x = MFMA32(kf[s], qf[s], x);
    if (MASKED) {
#pragma unroll
        for (int i = 0; i < 16; ++i) { const int kp = key0 + 32 * sub + crow(i, h); x[i] = (16 * kp + 31 <= t) ? x[i] : NEGBIG; }
    }
    const f32x2v mm = {m, m};
#pragma unroll
    for (int i = 0; i < 8; ++i) { f32x2v d = (f32x2v){x[2 * i], x[2 * i + 1]} - mm; x[2 * i] = __builtin_amdgcn_exp2f(d.x) * linv; x[2 * i + 1] = __builtin_amdgcn_exp2f(d.y) * linv; }
#pragma unroll
    for (int a = 0; a < 4; ++a) {
        float vm = (x[4 * a] + x[4 * a + 1]) + (x[4 * a + 2] + 0.5f * x[4 * a + 3]), vs = 0.5f * x[4 * a + 3];
        vm = quad_sum(vm); vs = quad_sum(vs);
        const int j = (key0 + 32 * sub) / 4 + 2 * a + h;
        if (head == 0) { const unsigned ad = (unsigned)(size_t)(IMP + tok_l * IMP_PITCH + j);
            asm volatile("ds_add_f32 %0, %1" :: "v"(ad), "v"(vm) : "memory");
            if (j + 1 < NSLC) asm volatile("ds_add_f32 %0, %1 offset:4" :: "v"(ad), "v"(vs) : "memory"); }
    }
#pragma unroll
    for (int s = 0; s < 2; ++s) {
        v4u pw; pw.x = cvtpk(x[8 * s], x[8 * s + 1]); pw.y = cvtpk(x[8 * s + 2], x[8 * s + 3]); pw.z = cvtpk(x[8 * s + 4], x[8 * s + 5]); pw.w = cvtpk(x[8 * s + 6], x[8 * s + 7]);
        const bf16x8 pf = __builtin_bit_cast(bf16x8, pw);
#pragma unroll
        for (int dvt = 0; dvt < 2; ++dvt) O[dvt] = MFMA32(__builtin_bit_cast(bf16x8, vf[s][dvt]), pf, O[dvt]);
    }
}

__device__ __forceinline__ void tile_qk(const LAS unsigned char* st, const bf16x8 (&qf)[6], int r, int h, f32x16& xa, f32x16& xb) {
#pragma unroll
    for (int i = 0; i < 16; ++i) { xa[i] = 0.f; xb[i] = 0.f; }
    const unsigned kb0 = (unsigned)(size_t)st + 64u * (unsigned)r + ((unsigned)((h ^ (r >> 2)) & 3) << 4);
    bf16x8 ka[6], kb[6];
#pragma unroll
    for (int s = 0; s < 6; ++s) {
        const unsigned ka_ = (kb0 ^ ((unsigned)(s & 1) << 5)) + (unsigned)((s >> 1) * 4096);
        ka[s] = *(const LAS bf16x8*)(size_t)ka_; kb[s] = *(const LAS bf16x8*)(size_t)(ka_ + 2048u);
    }
    __builtin_amdgcn_sched_barrier(0);
#pragma unroll
    for (int s = 0; s < 6; ++s) { xa = MFMA32(ka[s], qf[s], xa); xb = MFMA32(kb[s], qf[s], xb); }
}

template <int MODE>
__device__ __forceinline__ void tile_sm(const LAS unsigned char* st, int r, int h, unsigned selbit, float M, float& l, f32x16 (&O)[2], f32x16& xa, f32x16& xb, bool masked, int key0, int t) {
    if (masked) {
#pragma unroll
        for (int i = 0; i < 16; ++i) {
            const int ka = key0 + crow(i, h), kb = ka + 32; bool oa, ob;
            if (MODE == 0) { oa = (16 * ka + 31 <= t); ob = (16 * kb + 31 <= t); }
            else if (MODE == 2) { oa = (ka <= t); ob = (kb <= t); }
            else { oa = (ka <= t) && (ka > t - WIN); ob = (kb <= t) && (kb > t - WIN); }
            xa[i] = oa ? xa[i] : NEGBIG; xb[i] = ob ? xb[i] : NEGBIG; }
    }
    v4u vf[4][2];
    if (MODE != 0) {
        const unsigned vb = (unsigned)(size_t)st + (unsigned)ST_K + 128u * (unsigned)r + 8u * (unsigned)h + ((unsigned)((r >> 1) & 7) << 4);
#pragma unroll
        for (int q = 0; q < 4; ++q)
#pragma unroll
            for (int dvt = 0; dvt < 2; ++dvt) {
                const v2u lo = *(const LAS v2u*)(size_t)((vb ^ ((unsigned)(2 * q) << 4)) + (unsigned)(dvt * 4096)), hi = *(const LAS v2u*)(size_t)((vb ^ ((unsigned)(2 * q + 1) << 4)) + (unsigned)(dvt * 4096));
                vf[q][dvt].x = lo.x; vf[q][dvt].y = lo.y; vf[q][dvt].z = hi.x; vf[q][dvt].w = hi.y; }
    }
    const float mb = (MODE == 2 && selbit == 0u) ? 1e30f : M;
    const f32x2v mm = {mb, mb}; f32x2v ps = {0.f, 0.f};
#pragma unroll
    for (int i = 0; i < 8; ++i) {
        f32x2v d = (f32x2v){xa[2 * i], xa[2 * i + 1]} - mm; d.x = __builtin_amdgcn_exp2f(d.x); d.y = __builtin_amdgcn_exp2f(d.y); ps += d; xa[2 * i] = d.x; xa[2 * i + 1] = d.y;
        f32x2v e = (f32x2v){xb[2 * i], xb[2 * i + 1]} - mm; e.x = __builtin_amdgcn_exp2f(e.x); e.y = __builtin_amdgcn_exp2f(e.y); ps += e; xb[2 * i] = e.x; xb[2 * i + 1] = e.y;
    }
    l += ps.x + ps.y;
    if (MODE != 0) {
#pragma unroll
        for (int sub = 0; sub < 2; ++sub)
#pragma unroll
            for (int s = 0; s < 2; ++s) {
                v4u pw;
                if (sub == 0) { pw.x = cvtpk(xa[8 * s], xa[8 * s + 1]); pw.y = cvtpk(xa[8 * s + 2], xa[8 * s + 3]); pw.z = cvtpk(xa[8 * s + 4], xa[8 * s + 5]); pw.w = cvtpk(xa[8 * s + 6], xa[8 * s + 7]); }
                else { pw.x = cvtpk(xb[8 * s], xb[8 * s + 1]); pw.y = cvtpk(xb[8 * s + 2], xb[8 * s + 3]); pw.z = cvtpk(xb[8 * s + 4], xb[8 * s + 5]); pw.w = cvtpk(xb[8 * s + 6], xb[8 * s + 7]); }
                const bf16x8 pf = __builtin_bit_cast(bf16x8, pw);
#pragma unroll
                for (int dvt = 0; dvt < 2; ++dvt) O[dvt] = MFMA32(__builtin_bit_cast(bf16x8, vf[2 * sub + s][dvt]), pf, O[dvt]);
            }
    }
}

template <int MODE>
__device__ __forceinline__ void branch(LAS unsigned char* lds, const bf16* kbase, const bf16* vbase, int vlen, int tile0, int ntiles, int qt,
                                       const bf16x8 (&qf)[6], int t, int tok_l, int head, int r, int h, int tid,
                                       float& m, float& l, float linv, f32x16 (&O)[2]) {
    constexpr bool WITH_V = (MODE != 0);
    LAS float* IMP = (LAS float*)(lds + L_IMP);
    const LAS unsigned short* SEL = (const LAS unsigned short*)(lds + L_SEL);
    const int t0 = qt * 64, w = __builtin_amdgcn_readfirstlane(tid >> 6), lane = tid & 63;
    unsigned long long sel_lo = ~0ull, sel_hi = ~0ull;
    if (MODE == 2) { sel_lo = *(const LAS unsigned long long*)(SEL + tok_l * 8); sel_hi = *(const LAS unsigned long long*)(SEL + tok_l * 8 + 4); }
    DmaOff D; D.o0 = dma_src(w, lane, vlen); D.o1 = dma_src(w + 8, lane, vlen); D.o2 = dma_src(w + 16 < 20 ? w + 16 : 19, lane, vlen);
    NSA_WAIT_V(0);
    __builtin_amdgcn_s_barrier();
#pragma unroll
    for (int s = 0; s < NST - 1; ++s)
        if (s < ntiles) tile_dma<WITH_V>(lds + L_KV + s * ST_BYTES, kbase + (size_t)(tile0 + s) * 64 * DQK, vbase + (tile0 + s) * 64, D, w);
    for (int it = 0; it < ntiles; ++it) {
        const int j = tile0 + it, key0 = j * 64;
        if (it + NST - 2 < ntiles) { if (WITH_V) NSA_WAIT_V(4); else NSA_WAIT_V(2); } else NSA_WAIT_V(0);
        __builtin_amdgcn_s_barrier();
        if (it + NST - 1 < ntiles) tile_dma<WITH_V>(lds + L_KV + ((it + NST - 1) % NST) * ST_BYTES, kbase + (size_t)(j + NST - 1) * 64 * DQK, vbase + (j + NST - 1) * 64, D, w);
        const LAS unsigned char* st = lds + L_KV + (it % NST) * ST_BYTES;
        unsigned selbit = 1u; bool masked, active = true;
        if (MODE <= 1) masked = (16 * (key0 + 63) + 31 > t0);
        else if (MODE == 2) { selbit = (unsigned)(((j < 64) ? (sel_lo >> j) : (sel_hi >> (j - 64))) & 1ull); masked = (j == qt); active = __builtin_amdgcn_ballot_w64(selbit != 0u) != 0ull; }
        else masked = (j == qt) || (j + 8 == qt);
        if (active) {
            if (MODE != 1) { f32x16 xa, xb; tile_qk(st, qf, r, h, xa, xb); tile_sm<MODE == 1 ? 0 : MODE>(st, r, h, selbit, m, l, O, xa, xb, masked, key0, t); }
            else {
#pragma nounroll
                for (int sub = 0; sub < 2; ++sub) { if (masked) subtile<MODE, true>(st, IMP, sub, key0, qf, t, tok_l, head, r, h, selbit, m, l, linv, O);
                    else subtile<MODE, false>(st, IMP, sub, key0, qf, t, tok_l, head, r, h, selbit, m, l, linv, O); }
            }
        }
    }
    asm volatile("s_waitcnt lgkmcnt(0)" ::: "memory");
    __builtin_amdgcn_s_barrier();
}

__device__ __forceinline__ void topk_token(LAS float* IMP, LAS unsigned short* SEL, int tk, int cur, int lane) {
    const int j0 = lane, j1 = lane + 64;
    const bool v0 = j0 <= cur, v1 = j1 <= cur;
    const bool f0 = (j0 == 0) || (j0 == cur) || (j0 == cur - 1), f1 = (j1 == cur) || (j1 == cur - 1);
    const unsigned FORCED = 0x7149F2CBu;
    const unsigned k0 = v0 ? (f0 ? FORCED : __builtin_bit_cast(unsigned, IMP[tk * IMP_PITCH + j0]) + 1u) : 0u;
    const unsigned k1 = v1 ? (f1 ? FORCED : __builtin_bit_cast(unsigned, IMP[tk * IMP_PITCH + j1]) + 1u) : 0u;
    unsigned V = 0u;
#pragma nounroll
    for (int bit = 30; bit >= 0; --bit) {
        const unsigned cand = V | (1u << bit);
        const int c = __builtin_popcountll(__builtin_amdgcn_ballot_w64(k0 >= cand)) + __builtin_popcountll(__builtin_amdgcn_ballot_w64(k1 >= cand));
        V = (c >= NSEL) ? cand : V;
    }
    const unsigned long long gt0 = __builtin_amdgcn_ballot_w64(k0 > V), gt1 = __builtin_amdgcn_ballot_w64(k1 > V);
    const unsigned long long eq0 = __builtin_amdgcn_ballot_w64(k0 == V), eq1 = __builtin_amdgcn_ballot_w64(k1 == V);
    const int need = NSEL - (__builtin_popcountll(gt0) + __builtin_popcountll(gt1));
    const unsigned long long below = (lane == 0) ? 0ull : (~0ull >> (64 - lane));
    const int p0 = __builtin_popcountll(eq0 & below), p1 = __builtin_popcountll(eq0) + __builtin_popcountll(eq1 & below);
    const bool s0 = v0 && ((k0 > V) || ((k0 == V) && p0 < need)), s1 = v1 && ((k1 > V) || ((k1 == V) && p1 < need));
    const unsigned long long b0 = __builtin_amdgcn_ballot_w64(s0), b1 = __builtin_amdgcn_ballot_w64(s1);
    if (lane == 0) { *(LAS unsigned long long*)(SEL + tk * 8) = b0; *(LAS unsigned long long*)(SEL + tk * 8 + 4) = b1; }
}

__device__ __forceinline__ void attn_unit(Frame& F, int qt, int g) {
    unsigned char* ws = F.ws;
    LAS unsigned char* lds = F.lds + RING_OFF;
    const bf16* PROJ = (const bf16*)(ws + WS_PROJ); const bf16* QR = (const bf16*)(ws + WS_QR);
    const bf16* KSG = (const bf16*)(ws + WS_KSG) + (size_t)g * T * DQK; const bf16* KWG = (const bf16*)(ws + WS_KWG) + (size_t)g * T * DQK;
    const bf16* VST = (const bf16*)(ws + WS_VST) + (size_t)g * DV * T; const bf16* VWT = (const bf16*)(ws + WS_VWT) + (size_t)g * DV * T;
    const bf16* KCR = (const bf16*)(ws + WS_KCR) + (size_t)g * NCMPP * DQK; const bf16* VCT = (const bf16*)(ws + WS_VCT) + (size_t)g * DV * NCMPP;
    bf16* OB = (bf16*)(ws + WS_O);
    const int tid = F.tid, lane = F.lane, w = F.wave, r = lane & 31, h = lane >> 5, tok_l = 8 * w + (r >> 2), head = r & 3;
    const int t0 = qt * 64, t = t0 + tok_l, hg = 4 * g + head;
    LAS float* IMP = (LAS float*)(lds + L_IMP);
    LAS unsigned short* SEL = (LAS unsigned short*)(lds + L_SEL);
    for (int i = tid; i < 64 * IMP_PITCH; i += 512) IMP[i] = 0.f;
    bf16x8 qf[6];
#pragma unroll
    for (int s = 0; s < 6; ++s) { v4u qv = *(const GAS v4u*)(QR + (size_t)t * (NH * DQK) + hg * DQK + 16 * s + 8 * h);
        asm volatile("" : "+v"(qv));
        qf[s] = __builtin_bit_cast(bf16x8, qv); }
    unsigned gr0 = PROJ[(size_t)t * NP + C_GN + hg * 3 + 0], gr1 = PROJ[(size_t)t * NP + C_GN + hg * 3 + 1], gr2 = PROJ[(size_t)t * NP + C_GN + hg * 3 + 2];
    asm volatile("" : "+v"(gr0), "+v"(gr1), "+v"(gr2));
    const float g0 = sigmoidf_(bf2f(gr0)), g1 = sigmoidf_(bf2f(gr1)), g2 = sigmoidf_(bf2f(gr2));
    float Mc, Ms, Mw;
    { float q2 = 0.f;
#pragma unroll
      for (int s = 0; s < 6; ++s) { float a[8]; unpack8(__builtin_bit_cast(v4u, qf[s]), a);
#pragma unroll
          for (int i = 0; i < 8; ++i) q2 += a[i] * a[i]; }
      q2 += __shfl_xor(q2, 32);
      const float* sm = (const float*)(ws + WS_SMALL);
      const int nvb = (F.G == 256) ? 192 : F.G;
      float ks2 = 0.f, kw2 = 0.f, kc2 = 0.f;
#pragma unroll
      for (int i = 0; i < 4; ++i) { const int b = lane + 64 * i; if (b < nvb) { ks2 = fmaxf(ks2, sm[SM_KNS / 4 + g * 256 + b]); kw2 = fmaxf(kw2, sm[SM_KNW / 4 + g * 256 + b]); } }
#pragma unroll
      for (int i = 0; i < 8; ++i) kc2 = fmaxf(kc2, sm[SM_KNC / 4 + g * NCMPP + lane + 64 * i]);
#pragma unroll
      for (int o = 1; o < 64; o <<= 1) { ks2 = fmaxf(ks2, __shfl_xor(ks2, o)); kw2 = fmaxf(kw2, __shfl_xor(kw2, o)); kc2 = fmaxf(kc2, __shfl_xor(kc2, o)); }
      const float qn = sqrtf(q2) * 1.02f;
      Mc = qn * sqrtf(kc2) + 1e-3f; Ms = qn * sqrtf(ks2) + 1e-3f; Mw = qn * sqrtf(kw2) + 1e-3f;
      asm volatile("" : "+v"(Mc), "+v"(Ms), "+v"(Mw)); }
    f32x16 O[2];
#pragma unroll
    for (int i = 0; i < 16; ++i) { O[0][i] = 0.f; O[1][i] = 0.f; }
    float* OACC = (float*)(ws + WS_X1) + (size_t)t * 1024 + hg * DV + 4 * h;
    __syncthreads();
    {
        const int nmax = (t0 + 63 - 31) >> 4, ntiles = (nmax >> 6) + 1;
        float m = Mc, l = 0.f;
        branch<0>(lds, KCR, VCT, NCMPP, 0, ntiles, qt, qf, t, tok_l, head, r, h, tid, m, l, 0.f, O);
        const float lt = l + __shfl_xor(l, 32);
        const float linv = lt > 0.f ? 1.0f / lt : 0.f;
        branch<1>(lds, KCR, VCT, NCMPP, 0, ntiles, qt, qf, t, tok_l, head, r, h, tid, m, l, linv, O);
#pragma unroll
        for (int dvt = 0; dvt < 2; ++dvt)
#pragma unroll
            for (int a = 0; a < 4; ++a) { f32x4 v; v.x = g0 * O[dvt][4 * a]; v.y = g0 * O[dvt][4 * a + 1]; v.z = g0 * O[dvt][4 * a + 2]; v.w = g0 * O[dvt][4 * a + 3];
                *(GAS f32x4*)(OACC + 32 * dvt + 8 * a) = v; }
#pragma unroll
        for (int i = 0; i < 16; ++i) { O[0][i] = 0.f; O[1][i] = 0.f; }
    }
#if defined(ABL) && (ABL & 16)
    if (lane < 8) { *(LAS unsigned long long*)(SEL + (8 * w + lane) * 8) = ~0ull; *(LAS unsigned long long*)(SEL + (8 * w + lane) * 8 + 4) = ~0ull; }
#else
#pragma nounroll
    for (int q = 0; q < 8; ++q) topk_token(IMP, SEL, 8 * w + q, qt, lane);
#endif
    __syncthreads();
    {
        float m = Ms, l = 0.f;
        branch<2>(lds, KSG, VST, T, 0, qt + 1, qt, qf, t, tok_l, head, r, h, tid, m, l, 0.f, O);
        const float lt = l + __shfl_xor(l, 32);
        const float sc = lt > 0.f ? g1 / lt : 0.f;
#pragma unroll
        for (int dvt = 0; dvt < 2; ++dvt)
#pragma unroll
            for (int a = 0; a < 4; ++a) { f32x4 v = *(const GAS f32x4*)(OACC + 32 * dvt + 8 * a);
                v.x += sc * O[dvt][4 * a]; v.y += sc * O[dvt][4 * a + 1]; v.z += sc * O[dvt][4 * a + 2]; v.w += sc * O[dvt][4 * a + 3];
                *(GAS f32x4*)(OACC + 32 * dvt + 8 * a) = v; }
#pragma unroll
        for (int i = 0; i < 16; ++i) { O[0][i] = 0.f; O[1][i] = 0.f; }
    }
    {
        const int tile0 = qt >= 8 ? qt - 8 : 0;
        float m = Mw, l = 0.f;
        branch<3>(lds, KWG, VWT, T, tile0, qt - tile0 + 1, qt, qf, t, tok_l, head, r, h, tid, m, l, 0.f, O);
        const float lt = l + __shfl_xor(l, 32);
        const float sc = lt > 0.f ? g2 / lt : 0.f;
#pragma unroll
        for (int dvt = 0; dvt < 2; ++dvt)
#pragma unroll
            for (int a = 0; a < 4; ++a) { const f32x4 v = *(const GAS f32x4*)(OACC + 32 * dvt + 8 * a);
                v2u o; o.x = cvtpk(v.x + sc * O[dvt][4 * a], v.y + sc * O[dvt][4 * a + 1]); o.y = cvtpk(v.z + sc * O[dvt][4 * a + 2], v.w + sc * O[dvt][4 * a + 3]);
                *(GAS v2u*)(OB + (size_t)t * 1024 + hg * DV + 32 * dvt + 8 * a + 4 * h) = o; }
    }
}
__device__ __forceinline__ void p6_attention(Frame& F) {
    for (int u2 = 2 * F.bid; u2 < 512; u2 += ((u2 & 1) ? 2 * F.G - 1 : 1)) {
        const int u = u2 >> 1, g = u & 3, pr = u >> 2;
        attn_unit(F, (u2 & 1) ? 127 - pr : pr, g);
        __syncthreads();
    }
}
#undef MFMA32
}
constexpr int LX_TILE_E = LDS_X;
constexpr int LX_PSTART = LDS_X + 1408;
constexpr int LX_NTILES = LDS_X + 1408 + 272;
static_assert(LX_NTILES + 4 <= LDS_BYTES, "LDS_X");

__device__ __forceinline__ void p9_post_router(Frame& F) {
    unsigned char* ws = F.ws;
    const float* mod = (const float*)(ws + WS_SMALL + SM_MOD);
    const bf16* Z = (const bf16*)(ws + WS_Z);
    float* X1 = (float*)(ws + WS_X1);
    bf16* H2HI = (bf16*)(ws + WS_H2HI); bf16* H2LO = (bf16*)(ws + WS_H2LO);
    const bf16* WRH = (const bf16*)(ws + WS_WRT); const bf16* WRL = WRH + 64 * 2048;
    int* SELE = (int*)(ws + WS_TAB + TB_SELE); float* SELW = (float*)(ws + WS_TAB + TB_SELW); int* SELR = (int*)(ws + WS_TAB + TB_SELR);
    unsigned* CNT = (unsigned*)(F.ctl + CW_CNT);
    LAS float* RED = (LAS float*)(F.lds + RING_OFF);
    LAS float* LOG = (LAS float*)(F.lds + RING_OFF + 65536);
    LAS int* LCNT = (LAS int*)(F.lds + RING_OFF + 65536 + 8192);
    LAS int* LBASE = LCNT + 64;
    LAS int* LE = LBASE + 64;
    LAS int* LR = LE + 256;
    int tid = F.tid;
    LAS float* PA = (LAS float*)(F.lds + RING_OFF + 81920); LAS float* PB = PA + 2048; LAS float* PC = PB + 2048;
#pragma unroll
    for (int i = 0; i < 4; ++i) { const int c = tid + 512 * i; PA[c] = F.g_post_mix[c] * mod[2 * D + c]; PB[c] = F.g_pre_ffn[c] * (mod[4 * D + c] + 1.0f); PC[c] = mod[3 * D + c]; }
    __syncthreads();
    for (int rt = F.bid; rt < T / 32; rt += F.G) {
        asm volatile("" : "+v"(tid));
        const int lane = tid & 63, w = __builtin_amdgcn_readfirstlane(tid >> 6);
        const int row0 = rt * 32;
        if (tid < 64) LCNT[tid] = 0;
        {
            f32x4 zc[8], xc[8]; v2u zn[8];
            { const GAS v2u* zr = (const GAS v2u*)(Z + (size_t)(row0 + 4 * w) * D) + lane;
#pragma unroll
              for (int j = 0; j < 8; ++j) { const v2u z2 = zr[64 * j]; zc[j] = (f32x4){bflo(z2.x), bfhi(z2.x), bflo(z2.y), bfhi(z2.y)}; } }
#pragma nounroll
            for (int q = 0; q < 4; ++q) {
                const int row = row0 + 4 * w + q;
                { const GAS f32x4* xr = (const GAS f32x4*)(F.x + (size_t)row * D) + lane;
#pragma unroll
                  for (int j = 0; j < 8; ++j) xc[j] = xr[64 * j]; }
                if (q < 3) { const GAS v2u* zr = (const GAS v2u*)(Z + (size_t)(row + 1) * D) + lane;
#pragma unroll
                    for (int j = 0; j < 8; ++j) zn[j] = zr[64 * j]; }
                float ss = 0.f;
#pragma unroll
                for (int j = 0; j < 8; ++j) ss += (zc[j].x * zc[j].x + zc[j].y * zc[j].y) + (zc[j].z * zc[j].z + zc[j].w * zc[j].w);
                const float rstd = 1.0f / sqrtf(wave_sum(ss) * (1.0f / D) + RMS_EPS);
                float s2 = 0.f;
#pragma unroll
                for (int j = 0; j < 8; ++j) { const int col = 4 * (lane + 64 * j);
                    const f32x4 pa = *(const LAS f32x4*)(PA + col);
                    zc[j] = xc[j] + (zc[j] * rstd) * pa;
                    s2 += (zc[j].x * zc[j].x + zc[j].y * zc[j].y) + (zc[j].z * zc[j].z + zc[j].w * zc[j].w);
                    *((GAS f32x4*)(X1 + (size_t)row * D) + lane + 64 * j) = zc[j]; }
                const float rstd2 = 1.0f / sqrtf(wave_sum(s2) * (1.0f / D) + RMS_EPS);
#pragma unroll
                for (int j = 0; j < 8; ++j) { const int col = 4 * (lane + 64 * j);
                    const f32x4 pb = *(const LAS f32x4*)(PB + col), pc = *(const LAS f32x4*)(PC + col);
                    const f32x4 hv = (zc[j] * rstd2) * pb + pc;
                    const unsigned h0 = f2bf(hv.x), h1 = f2bf(hv.y), h2 = f2bf(hv.z), h3 = f2bf(hv.w);
                    v2u hi; hi.x = h0 | (h1 << 16); hi.y = h2 | (h3 << 16);
                    v2u lo; lo.x = pk2(hv.x - bf2f(h0), hv.y - bf2f(h1)); lo.y = pk2(hv.z - bf2f(h2), hv.w - bf2f(h3));
                    *((GAS v2u*)(H2HI + (size_t)row * D) + lane + 64 * j) = hi; *((GAS v2u*)(H2LO + (size_t)row * D) + lane + 64 * j) = lo; }
                if (q < 3) {
#pragma unroll
                    for (int j = 0; j < 8; ++j) zc[j] = (f32x4){bflo(zn[j].x), bfhi(zn[j].x), bflo(zn[j].y), bfhi(zn[j].y)}; }
            }
        }
        VM_WAIT(); __syncthreads();
        {
            const int fr = lane & 15, fq = lane >> 4;
            f32x4 acc[2][4];
#pragma unroll
            for (int a = 0; a < 2; ++a)
#pragma unroll
                for (int b = 0; b < 4; ++b) acc[a][b] = (f32x4){0.f, 0.f, 0.f, 0.f};
            v4u ahn[2], aln[2], bhn[4], bln[4];
#define P9_LOAD(ks_) do { const int kof = 256 * w + 32 * (ks_) + 8 * fq; \
                _Pragma("unroll") for (int a = 0; a < 2; ++a) { ahn[a] = *(const GAS v4u*)(H2HI + (size_t)(row0 + 16 * a + fr) * D + kof); aln[a] = *(const GAS v4u*)(H2LO + (size_t)(row0 + 16 * a + fr) * D + kof); } \
                _Pragma("unroll") for (int b = 0; b < 4; ++b) { bhn[b] = *(const GAS v4u*)(WRH + (size_t)(16 * b + fr) * D + kof); bln[b] = *(const GAS v4u*)(WRL + (size_t)(16 * b + fr) * D + kof); } } while (0)
            P9_LOAD(0);
#pragma nounroll
            for (int ks = 0; ks < 8; ++ks) {
                bf16x8 ah[2], al[2], bh[4], bl[4];
#pragma unroll
                for (int a = 0; a < 2; ++a) { ah[a] = __builtin_bit_cast(bf16x8, ahn[a]); al[a] = __builtin_bit_cast(bf16x8, aln[a]); }
#pragma unroll
                for (int b = 0; b < 4; ++b) { bh[b] = __builtin_bit_cast(bf16x8, bhn[b]); bl[b] = __builtin_bit_cast(bf16x8, bln[b]); }
                if (ks < 7) P9_LOAD(ks + 1);
#pragma unroll
                for (int a = 0; a < 2; ++a)
#pragma unroll
                    for (int b = 0; b < 4; ++b) {
                        acc[a][b] = __builtin_amdgcn_mfma_f32_16x16x32_bf16(ah[a], bh[b], acc[a][b], 0, 0, 0);
                        acc[a][b] = __builtin_amdgcn_mfma_f32_16x16x32_bf16(al[a], bh[b], acc[a][b], 0, 0, 0);
                        acc[a][b] = __builtin_amdgcn_mfma_f32_16x16x32_bf16(ah[a], bl[b], acc[a][b], 0, 0, 0);
                    }
            }
#undef P9_LOAD
#pragma unroll
            for (int a = 0; a < 2; ++a)
#pragma unroll
                for (int b = 0; b < 4; ++b)
#pragma unroll
                    for (int i = 0; i < 4; ++i) RED[(w * 32 + 16 * a + 4 * fq + i) * 64 + 16 * b + fr] = acc[a][b][i];
        }
        __syncthreads();
        for (int idx = tid; idx < 32 * 64; idx += 512) { float s = 0.f;
#pragma unroll
            for (int ww = 0; ww < NWAVES; ++ww) s += RED[ww * 2048 + idx];
            LOG[idx] = s; }
        __syncthreads();
#pragma nounroll
        for (int q = 0; q < 4; ++q) {
            const int rl = 4 * w + q, row = row0 + rl, e = lane;
            const float aff = 1.0f / (1.0f + __expf(-LOG[rl * 64 + e]));
            const float biased = aff + F.router_bias[e];
            float v1 = biased; int i1 = e;
#pragma unroll
            for (int o = 1; o < 8; o <<= 1) { const float ov = __shfl_xor(v1, o); const int oi = __shfl_xor(i1, o); if (ov > v1 || (ov == v1 && oi < i1)) { v1 = ov; i1 = oi; } }
            float v2 = (e == i1) ? -3.0e38f : biased;
#pragma unroll
            for (int o = 1; o < 8; o <<= 1) v2 = fmaxf(v2, __shfl_xor(v2, o));
            const float gs = v1 + v2; const int mg = e >> 3;
            int grank = 0;
#pragma unroll
            for (int gp = 0; gp < 8; ++gp) { const float og = __shfl(gs, gp * 8); grank += (og > gs || (og == gs && gp < mg)) ? 1 : 0; }
            const float s = (grank < 4) ? biased : -1e30f;
            int rank = 0;
            for (int ep = 0; ep < 64; ++ep) { const float ov = __shfl(s, ep); rank += (ov > s || (ov == s && ep < e)) ? 1 : 0; }
            const bool sel = rank < TOPK;
            const float wsum = wave_sum(sel ? aff : 0.f);
            if (sel) { const int lr = __hip_atomic_fetch_add(LCNT + e, 1, __ATOMIC_RELAXED, __HIP_MEMORY_SCOPE_WORKGROUP);
                LE[rl * 8 + rank] = e; LR[rl * 8 + rank] = lr;
                SELE[(size_t)row * 8 + rank] = e; SELW[(size_t)row * 8 + rank] = aff / wsum * 2.5f; }
        }
        __syncthreads();
        if (tid < 64) LBASE[tid] = (int)__hip_atomic_fetch_add(CNT + tid, (unsigned)LCNT[tid], __ATOMIC_RELAXED, __HIP_MEMORY_SCOPE_AGENT);
        __syncthreads();
        if (tid < 256) SELR[(size_t)row0 * 8 + tid] = LBASE[LE[tid]] + LR[tid];
        __syncthreads();
    }
}

__device__ __forceinline__ void p10_tables(Frame& F) {
    unsigned char* ws = F.ws;
    const int* SELE = (const int*)(ws + WS_TAB + TB_SELE); const float* SELW = (const float*)(ws + WS_TAB + TB_SELW); const int* SELR = (const int*)(ws + WS_TAB + TB_SELR);
    int* POS = (int*)(ws + WS_TAB + TB_POS); int* TOK = (int*)(ws + WS_TAB + TB_TOK); float* WROW = (float*)(ws + WS_TAB + TB_WROW);
    unsigned* CNT = (unsigned*)(F.ctl + CW_CNT);
    LAS int* tile_e = (LAS int*)(F.lds + LX_TILE_E); LAS int* pstart = (LAS int*)(F.lds + LX_PSTART); LAS int* ntl = (LAS int*)(F.lds + LX_NTILES);
    LAS int* lcnt = (LAS int*)(F.lds + RING_OFF);
    if (F.tid < 64) {
        const int e = F.tid, c = (int)__hip_atomic_load(CNT + e, __ATOMIC_RELAXED, __HIP_MEMORY_SCOPE_AGENT), nt = (c + 255) >> 8;
        int incl = nt;
#pragma unroll
        for (int o = 1; o < 64; o <<= 1) { const int v = __shfl_up(incl, o); if (e >= o) incl += v; }
        const int before = incl - nt, total = __shfl(incl, 63);
        lcnt[e] = c; pstart[e] = before * 256;
        for (int q = 0; q < nt; ++q) tile_e[before + q] = e;
        if (e < 32) tile_e[total + e] = NE;
        if (e == 0) { pstart[NE] = total * 256; pstart[NE + 1] = (total + 32) * 256; ntl[0] = total + 32; }
    }
    __syncthreads();
    const int gt = F.bid * 512 + F.tid, NT = F.G * 512;
    for (int idx = gt; idx < T * TOPK; idx += NT) { const int e = SELE[idx], pos = pstart[e] + SELR[idx]; TOK[pos] = idx >> 3; WROW[pos] = SELW[idx]; POS[idx] = pos; }
    for (int t = gt; t < T; t += NT) { TOK[pstart[NE] + t] = t; WROW[pstart[NE] + t] = 1.0f; }
    for (int e = F.bid; e < NE; e += F.G) { const int c = lcnt[e];
        for (int s = pstart[e] + c + F.tid; s < pstart[e + 1]; s += 512) { TOK[s] = 0; WROW[s] = 0.f; } }
    __syncthreads();
}

__device__ __forceinline__ void p13_final(Frame& F) {
    unsigned char* ws = F.ws;
    const float* mod = (const float*)(ws + WS_SMALL + SM_MOD);
    const float* X1 = (const float*)(ws + WS_X1); const bf16* YB = (const bf16*)(ws + WS_YB);
    const int* POS = (const int*)(ws + WS_TAB + TB_POS);
    const LAS int* pstart = (const LAS int*)(F.lds + LX_PSTART);
    const int gw = F.bid * NWAVES + F.wave, NGW = F.G * NWAVES, lane = F.lane;
    const int shbase = pstart[NE];
    for (int row = gw; row < T; row += NGW) {
        float y[4][8];
#pragma unroll
        for (int j = 0; j < 4; ++j)
#pragma unroll
            for (int i = 0; i < 8; ++i) y[j][i] = 0.f;
        const int posv = POS[(size_t)row * 8 + (lane & 7)];
#pragma unroll
        for (int kb = 0; kb < 3; ++kb) {
            v4u w[3][4];
#pragma unroll
            for (int kk = 0; kk < 3; ++kk) { const int k = 3 * kb + kk;
                const int slot = (k < TOPK) ? __shfl(posv, k) : shbase + row;
                const bf16* yr = YB + (size_t)slot * D;
#pragma unroll
                for (int j = 0; j < 4; ++j) w[kk][j] = *(const GAS v4u*)(yr + 8 * (lane + 64 * j)); }
#pragma unroll
            for (int kk = 0; kk < 3; ++kk)
#pragma unroll
                for (int j = 0; j < 4; ++j) { float a[8]; unpack8(w[kk][j], a);
#pragma unroll
                    for (int i = 0; i < 8; ++i) y[j][i] += a[i]; }
        }
        float ss = 0.f;
#pragma unroll
        for (int j = 0; j < 4; ++j)
#pragma unroll
            for (int i = 0; i < 8; ++i) ss += y[j][i] * y[j][i];
        const float rstd = 1.0f / sqrtf(wave_sum(ss) * (1.0f / D) + RMS_EPS);
#pragma unroll
        for (int j = 0; j < 4; ++j) { const int col = 8 * (lane + 64 * j);
#pragma unroll
            for (int hh = 0; hh < 2; ++hh) {
                const f32x4 x1 = *(const GAS f32x4*)(X1 + (size_t)row * D + col + 4 * hh), g = *(const GAS f32x4*)(F.g_post_ffn + col + 4 * hh), gt = *(const GAS f32x4*)(mod + 5 * D + col + 4 * hh);
                f32x4 yy; yy.x = y[j][4 * hh]; yy.y = y[j][4 * hh + 1]; yy.z = y[j][4 * hh + 2]; yy.w = y[j][4 * hh + 3];
                *(GAS f32x4*)(F.out + (size_t)row * D + col + 4 * hh) = x1 + gt * ((yy * rstd) * g); } }
    }
}
#if defined(DIAG) && DIAG
constexpr int CW_DIAG = 5120;
__device__ __forceinline__ float wave_max(float v) {
#pragma unroll
    for (int o = 1; o < 64; o <<= 1) v = fmaxf(v, __shfl_xor(v, o));
    return v;
}
__device__ __forceinline__ float ldbf(const bf16* p) { return bf2f(*p); }
__device__ __forceinline__ void diag_max(gu32* w, float v) { if (v == v) atomicMax((unsigned*)w, __builtin_bit_cast(unsigned, fabsf(v))); else atomicMax((unsigned*)w, 0x7f000000u); }

__device__ __forceinline__ int diag_sample_t(int s) {
    const int special[32] = {0, 1, 5, 30, 31, 32, 46, 47, 48, 62, 63, 64, 65, 95, 127, 128, 200, 511, 512, 513, 575, 576, 1000, 1023, 1024, 1025, 1087, 1088, 2047, 4095, 8190, 8191};
    int t = (int)(((unsigned)s * 2654435761u) >> 19);
#pragma unroll
    for (int i = 0; i < 32; ++i) t = (s == i) ? special[i] : t;
    return t;
}

__device__ __forceinline__ void diag_cs(float pos, int i, float& c, float& sn) {
    const float inv[12] = {1.000000000e+00f, 3.350316475e-01f, 1.122462048e-01f, 3.760603093e-02f, 1.259921050e-02f, 4.221134251e-03f, 1.414213562e-03f, 4.738062997e-04f, 1.587401052e-04f, 5.318295897e-05f, 1.781797436e-05f, 5.969585306e-06f};
    float iv = inv[0];
#pragma unroll
    for (int q = 1; q < 12; ++q) iv = (i == q) ? inv[q] : iv;
    const float ang = pos * iv;
    const double a = (double)ang, k = __builtin_rint(a * 0.15915494309189535), r = a - k * 6.283185307179586;
    c = __cosf((float)r); sn = __sinf((float)r);
}
__device__ __forceinline__ void diag_attention(Frame& F) {
    unsigned char* ws = F.ws;
    const bf16* PROJ = (const bf16*)(ws + WS_PROJ); const bf16* QR = (const bf16*)(ws + WS_QR);
    const bf16* OB = (const bf16*)(ws + WS_O);
    LAS float* L = (LAS float*)(F.lds + RING_OFF + F.wave * 12288);
    LAS float* Psum = L; LAS float* pbuf = L + 512; LAS float* score = L + 1536; LAS float* self_ = L + 1664; LAS float* qv = L + 1792; LAS float* ocmp = L + 1920;
    const int gw = F.bid * NWAVES + F.wave, NGW = F.G * NWAVES, lane = F.lane;
    for (int s = gw; s < 1024; s += NGW) {
        const int t = diag_sample_t(s >> 2), g = s & 3;
        const bf16* KSG = (const bf16*)(ws + WS_KSG) + (size_t)g * T * DQK; const bf16* KWG = (const bf16*)(ws + WS_KWG) + (size_t)g * T * DQK;
        const bf16* VST = (const bf16*)(ws + WS_VST) + (size_t)g * DV * T; const bf16* VWT = (const bf16*)(ws + WS_VWT) + (size_t)g * DV * T;
        const bf16* KCR = (const bf16*)(ws + WS_KCR) + (size_t)g * NCMPP * DQK; const bf16* VCT = (const bf16*)(ws + WS_VCT) + (size_t)g * DV * NCMPP;
        for (int i = lane; i < 512; i += 64) Psum[i] = 0.f;
        LDS_WAIT();
        for (int hd = 0; hd < 4; ++hd) {
            const int hg = 4 * g + hd;
            for (int i = lane; i < DQK; i += 64) qv[i] = ldbf(QR + (size_t)t * (NH * DQK) + hg * DQK + i);
            LDS_WAIT();
            float sv[8]; float mx = -1e30f;
#pragma unroll
            for (int i = 0; i < 8; ++i) { const int n = lane + 64 * i; const bool ok = (n < NCMP) && (16 * n + 31 <= t); float d = 0.f;
                if (ok) for (int k = 0; k < DQK; ++k) d += qv[k] * ldbf(KCR + (size_t)n * DQK + k);
                sv[i] = ok ? d : -1e30f; mx = ok ? fmaxf(mx, d) : mx; }
            mx = wave_max(mx);
            float sum = 0.f;
#pragma unroll
            for (int i = 0; i < 8; ++i) { const float p = (sv[i] > -1e29f) ? exp2f(sv[i] - mx) : 0.f; sv[i] = p; sum += p; }
            sum = wave_sum(sum);
            const float inv = sum > 0.f ? 1.0f / sum : 0.f;
#pragma unroll
            for (int i = 0; i < 8; ++i) { const int n = lane + 64 * i; const float p = sv[i] * inv; pbuf[n] = p; Psum[n] += p; }
            LDS_WAIT();
            { float o = 0.f; for (int n = 0; n < NCMP; ++n) o += pbuf[n] * ldbf(VCT + (size_t)lane * NCMPP + n); ocmp[hd * 64 + lane] = o; }
            LDS_WAIT();
        }
        const int cur = t >> 6;
        for (int j = lane; j < NSLC; j += 64) {
            float imp = 0.f;
            for (int n = 0; n < NCMP; ++n) { const int lo = 16 * n, hi = lo + 32; int a = lo > 64 * j ? lo : 64 * j, b = hi < 64 * j + 64 ? hi : 64 * j + 64; const int ov = b - a; if (ov > 0) imp += Psum[n] * ((float)ov * (1.0f / 32.0f)); }
            const bool valid = (j * 64 <= t), forced = (j == 0) || (j == cur) || (j == cur - 1);
            score[j] = valid ? (forced ? 1e30f : imp) : -1e30f;
        }
        LDS_WAIT();
        for (int j = lane; j < NSLC; j += 64) { int rank = 0; const float sj = score[j];
            for (int jp = 0; jp < NSLC; ++jp) { const float v = score[jp]; rank += (v > sj || (v == sj && jp < j)) ? 1 : 0; }
            self_[j] = (rank < NSEL && sj > -0.5e30f) ? 1.f : 0.f; }
        LDS_WAIT();
        for (int hd = 0; hd < 4; ++hd) {
            const int hg = 4 * g + hd;
            for (int i = lane; i < DQK; i += 64) qv[i] = ldbf(QR + (size_t)t * (NH * DQK) + hg * DQK + i);
            LDS_WAIT();
            float oslc = 0.f;
            { float mx = -1e30f; int nb = 0;
              for (int j = 0; j < NSLC; ++j) { if (self_[j] == 0.f) continue; const int kp = 64 * j + lane; float d = -1e30f;
                  if (kp <= t) { d = 0.f; for (int k = 0; k < DQK; ++k) d += qv[k] * ldbf(KSG + (size_t)kp * DQK + k); mx = fmaxf(mx, d); }
                  pbuf[nb * 64 + lane] = d; ++nb; }
              mx = wave_max(mx);
              float sum = 0.f;
              for (int b = 0; b < nb; ++b) { const float d = pbuf[b * 64 + lane]; const float p = (d > -1e29f) ? exp2f(d - mx) : 0.f; pbuf[b * 64 + lane] = p; sum += p; }
              sum = wave_sum(sum);
              LDS_WAIT();
              int b = 0;
              for (int j = 0; j < NSLC; ++j) { if (self_[j] == 0.f) continue;
                  for (int kk = 0; kk < 64; ++kk) oslc += pbuf[b * 64 + kk] * ldbf(VST + (size_t)lane * T + 64 * j + kk);
                  ++b; }
              oslc = sum > 0.f ? oslc / sum : 0.f; }
            LDS_WAIT();
            float owin = 0.f;
            { float mx = -1e30f;
              for (int i = 0; i < 8; ++i) { const int kp = t - 511 + 64 * i + lane; float d = -1e30f;
                  if (kp >= 0 && kp <= t) { d = 0.f; for (int k = 0; k < DQK; ++k) d += qv[k] * ldbf(KWG + (size_t)kp * DQK + k); mx = fmaxf(mx, d); }
                  pbuf[i * 64 + lane] = d; }
              mx = wave_max(mx);
              float sum = 0.f;
              for (int i = 0; i < 8; ++i) { const float d = pbuf[i * 64 + lane]; const float p = (d > -1e29f) ? exp2f(d - mx) : 0.f; pbuf[i * 64 + lane] = p; sum += p; }
              sum = wave_sum(sum);
              LDS_WAIT();
              for (int i = 0; i < 512; ++i) { const int kp = t - 511 + i; if (kp >= 0) owin += pbuf[i] * ldbf(VWT + (size_t)lane * T + kp); }
              owin = sum > 0.f ? owin / sum : 0.f; }
            const float g0 = sigmoidf_(ldbf(PROJ + (size_t)t * NP + C_GN + hg * 3 + 0)), g1 = sigmoidf_(ldbf(PROJ + (size_t)t * NP + C_GN + hg * 3 + 1)), g2 = sigmoidf_(ldbf(PROJ + (size_t)t * NP + C_GN + hg * 3 + 2));
            const float ref = g0 * ocmp[hd * 64 + lane] + g1 * oslc + g2 * owin;
            const float got = ldbf(OB + (size_t)t * 1024 + hg * DV + lane);
            const float df = wave_max(fabsf(got - ref) == fabsf(got - ref) ? fabsf(got - ref) : 3e38f), rf = wave_max(fabsf(ref));
            if (lane == 0) { diag_max(F.ctl + CW_DIAG + 0, df / fmaxf(rf, 1e-6f)); diag_max(F.ctl + CW_DIAG + 1, rf); }
            LDS_WAIT();
        }
    }
}
__device__ __forceinline__ void diag_rope_cmp(Frame& F) {
    unsigned char* ws = F.ws;
    const bf16* PROJ = (const bf16*)(ws + WS_PROJ); const bf16* QR = (const bf16*)(ws + WS_QR);
    const bf16* KSG = (const bf16*)(ws + WS_KSG); const bf16* KWG = (const bf16*)(ws + WS_KWG); const bf16* KCG = (const bf16*)(ws + WS_KCG); const bf16* VCG = (const bf16*)(ws + WS_VCG);
    const bf16* KCR = (const bf16*)(ws + WS_KCR); const bf16* VCT = (const bf16*)(ws + WS_VCT);
    const bf16* VST = (const bf16*)(ws + WS_VST); const bf16* VWT = (const bf16*)(ws + WS_VWT);
    const int gw = F.bid * NWAVES + F.wave, NGW = F.G * NWAVES, lane = F.lane;
    LAS float* hid = (LAS float*)(F.lds + RING_OFF + F.wave * 12288);
    LAS float* ov = hid + 384;
    for (int s = gw; s < 256; s += NGW) {
        const int t = diag_sample_t(s); const float pos = (float)F.positions[t];
        float md = 0.f;
        for (int idx = lane; idx < (NH + 2 * NG) * DQK; idx += 64) {
            const int hh = idx / DQK, d = idx % DQK;
            const bf16* src; const bf16* dst; float scale = 1.0f;
            if (hh < NH) { src = PROJ + (size_t)t * NP + C_Q + hh * DQK; dst = QR + (size_t)t * (NH * DQK) + hh * DQK; scale = 0.14724444236568886f; }
            else if (hh < NH + NG) { const int g = hh - NH; src = PROJ + (size_t)t * NP + C_KS + g * DQK; dst = KSG + ((size_t)g * T + t) * DQK; }
            else { const int g = hh - NH - NG; src = PROJ + (size_t)t * NP + C_KW + g * DQK; dst = KWG + ((size_t)g * T + t) * DQK; }
            float ref;
            if (d < ROT) { const int i = d % HALFROT; float c, sn; diag_cs(pos, i, c, sn);
                const float x1 = ldbf(src + i), x2 = ldbf(src + HALFROT + i); ref = (d < HALFROT) ? (x1 * c - x2 * sn) : (x2 * c + x1 * sn); }
            else ref = ldbf(src + d);
            ref *= scale;
            md = fmaxf(md, fabsf(ldbf(dst + d) - ref));
        }
        for (int idx = lane; idx < NG * DV; idx += 64) { const int g = idx / DV, dv = idx % DV;
            md = fmaxf(md, fabsf(ldbf(VST + ((size_t)g * DV + dv) * T + t) - ldbf(PROJ + (size_t)t * NP + C_VS + idx)));
            md = fmaxf(md, fabsf(ldbf(VWT + ((size_t)g * DV + dv) * T + t) - ldbf(PROJ + (size_t)t * NP + C_VW + idx)));
            md = fmaxf(md, fabsf(ldbf(VCG + ((size_t)g * T + t) * DV + dv) - ldbf(PROJ + (size_t)t * NP + C_VC + idx))); }
        for (int idx = lane; idx < NG * DQK; idx += 64) { const int g = idx / DQK, d = idx % DQK;
            md = fmaxf(md, fabsf(ldbf(KCG + ((size_t)g * T + t) * DQK + d) - ldbf(PROJ + (size_t)t * NP + C_KC + idx))); }
        md = wave_max(md);
        if (lane == 0) diag_max(F.ctl + CW_DIAG + 2, md);
    }
    for (int s = gw; s < 128; s += NGW) {
        const int g = s & 3; int n = (int)(((unsigned)(s >> 2) * 2654435761u) >> 23) % NCMP; if ((s >> 2) == 0) n = 0; if ((s >> 2) == 1) n = NCMP - 1;
        for (int c = lane; c < 384; c += 64) { float a = 0.f;
            for (int l = 0; l < 32; ++l) for (int d = 0; d < DQK; ++d) a += (ldbf(KCG + ((size_t)g * T + 16 * n + l) * DQK + d) + F.cmp_pos_k[l * DQK + d]) * F.cmp_k_w1[(size_t)(l * DQK + d) * 384 + c];
            hid[c] = a / (1.0f + __expf(-a)); }
        LDS_WAIT();
        for (int j = lane; j < DQK; j += 64) { float a = 0.f; for (int c = 0; c < 384; ++c) a += hid[c] * F.cmp_k_w2[c * DQK + j]; ov[j] = a; }
        LDS_WAIT();
        float md = 0.f, mr = 0.f;
        { const float pos = (float)F.positions[16 * n + 31];
          for (int j = lane; j < DQK; j += 64) { float ref = ov[j];
              if (j < ROT) { const int i = j % HALFROT; float c, sn; diag_cs(pos, i, c, sn);
                  ref = (j < HALFROT) ? (ov[i] * c - ov[HALFROT + i] * sn) : (ov[HALFROT + i] * c + ov[i] * sn); }
              md = fmaxf(md, fabsf(ldbf(KCR + ((size_t)g * NCMPP + n) * DQK + j) - ref)); mr = fmaxf(mr, fabsf(ref)); } }
        LDS_WAIT();
        for (int c = lane; c < 256; c += 64) { float a = 0.f;
            for (int l = 0; l < 32; ++l) for (int d = 0; d < DV; ++d) a += (ldbf(VCG + ((size_t)g * T + 16 * n + l) * DV + d) + F.cmp_pos_v[l * DV + d]) * F.cmp_v_w1[(size_t)(l * DV + d) * 256 + c];
            hid[c] = a / (1.0f + __expf(-a)); }
        LDS_WAIT();
        { float a = 0.f; for (int c = 0; c < 256; ++c) a += hid[c] * F.cmp_v_w2[c * DV + lane];
          md = fmaxf(md, fabsf(ldbf(VCT + ((size_t)g * DV + lane) * NCMPP + n) - a)); mr = fmaxf(mr, fabsf(a)); }
        LDS_WAIT();
        md = wave_max(md); mr = wave_max(mr);
        if (lane == 0) { diag_max(F.ctl + CW_DIAG + 3, md / fmaxf(mr, 1e-6f)); diag_max(F.ctl + CW_DIAG + 4, mr); }
    }
}
#endif
struct Args { const void* in[29]; float* out; unsigned char* ws; };
__global__ void __launch_bounds__(NWAVES * 64, 2) fwd_kernel(Args args) {
    extern __shared__ __attribute__((aligned(16))) unsigned char lds[];
    Frame F;
    F.lds = (LAS unsigned char*)lds;
    F.MISC = (volatile LAS unsigned*)(F.lds + MISC_OFF);
    F.tid = threadIdx.x; F.lane = F.tid & 63; F.wave = __builtin_amdgcn_readfirstlane(F.tid >> 6);
    F.G = gridDim.x; F.bid = blockIdx.x;
    unsigned char* ws = args.ws; F.ws = ws;
    F.ctl = (gu32*)(ws + WS_CTL);
    F.x = (const float*)args.in[0]; F.c = (const float*)args.in[1]; F.positions = (const int*)args.in[2];
    F.w_ada = (const float*)args.in[3]; F.b_ada = (const float*)args.in[4];
    F.g_pre_mix = (const float*)args.in[5]; F.g_post_mix = (const float*)args.in[6]; F.g_pre_ffn = (const float*)args.in[7]; F.g_post_ffn = (const float*)args.in[8];
    F.w_in = (const float*)args.in[9];
    F.cmp_pos_k = (const float*)args.in[10]; F.cmp_k_w1 = (const float*)args.in[11]; F.cmp_k_w2 = (const float*)args.in[12];
    F.cmp_pos_v = (const float*)args.in[13]; F.cmp_v_w1 = (const float*)args.in[14]; F.cmp_v_w2 = (const float*)args.in[15];
    F.pool_w = (const float*)args.in[16]; F.pool_scale = (const float*)args.in[17];
    F.w_pool_up = (const float*)args.in[18]; F.w_nsa_up = (const float*)args.in[19]; F.w_out = (const float*)args.in[20];
    F.w_router = (const float*)args.in[21]; F.router_bias = (const float*)args.in[22];
    F.w_exp_gate = (const float*)args.in[23]; F.w_exp_up = (const float*)args.in[24]; F.w_exp_down = (const float*)args.in[25];
    F.w_sh_gate = (const float*)args.in[26]; F.w_sh_up = (const float*)args.in[27]; F.w_sh_down = (const float*)args.in[28];
    F.out = args.out;
    for (int u = F.tid; u < (LDS_BYTES - LDSCTL_OFF) / 4; u += NWAVES * 64) ((LAS unsigned*)(F.lds + LDSCTL_OFF))[u] = 0u;
    __syncthreads();
    XcdBarrier bar = xcd_barrier_post((unsigned*)(F.ctl + CW_BAR), F.MISC + 8);
#define GRID_BAR() do { xcd_barrier(bar); TSTAMP(); int _t = threadIdx.x; asm volatile("" : "+v"(_t)); F.tid = _t; F.lane = _t & 63; F.wave = __builtin_amdgcn_readfirstlane(_t >> 6); } while (0)
    LAS unsigned char* ring = F.lds + RING_OFF;
#if defined(TIMEPH)
    int n_ts = 0; unsigned long long ts_prev = __builtin_amdgcn_s_memrealtime(); float ts_sel = 0.f;
#define TSTAMP() do { const unsigned long long _n = __builtin_amdgcn_s_memrealtime(); if (n_ts == TIMEPH || TIMEPH == 99) ts_sel += (float)(_n - ts_prev) * 0.01f; ts_prev = _n; ++n_ts; } while (0)
#else
#define TSTAMP() do { } while (0)
#endif
    const int vcu = (F.G % 8 == 0) ? (F.bid % 8) * (F.G / 8) + F.bid / 8 : F.bid;

#if PH_HI > 0 && PH_LO <= 0
    for (int rep_ = 0; rep_ < ((REP_PHASE == 0) ? 1 + REP_EXTRA : 1); ++rep_) {
    p0_prologue(F);
    conv_pull(F, CONV_P0);
    GRID_BAR();
    }
#endif
#if PH_HI > 1 && PH_LO <= 1
    for (int rep_ = 0; rep_ < ((REP_PHASE == 1) ? 1 + REP_EXTRA : 1); ++rep_) {
    p1_norm(F);
    GRID_BAR();
    }
#endif
#if PH_HI > 2 && PH_LO <= 2
    for (int rep_ = 0; rep_ < ((REP_PHASE == 2) ? 1 + REP_EXTRA : 1); ++rep_) {
    {
        pg8::Gemm g{(const bf16*)(ws + WS_H), 2048, 2048};
        SchedPlain S{32, 32, F.G, F.bid, (const char*)(ws + WS_WIN), 4096u, 4096};
        EpiBf16 E{(bf16*)(ws + WS_PROJ), NP, 0, 0};
        pg8::gemm_phase<EpiBf16, SchedPlain>(ring, g, S, E);
    }
    GRID_BAR();
    }
#endif
#if PH_HI > 3 && PH_LO <= 3
    for (int rep_ = 0; rep_ < ((REP_PHASE == 3) ? 1 + REP_EXTRA : 1); ++rep_) {
    {
        const bool split = (F.G == 256);
        const bool tailer = split ? ((F.bid & 3) == 0) : (F.bid < 64);
        pg8::Gemm g{(const bf16*)(ws + WS_H), 2048, 2048};
        SchedInTail S{tailer ? (split ? (F.bid >> 2) : F.bid) : -1, (const char*)(ws + WS_WIN), 4096u, 4096}; EpiBf16 E{(bf16*)(ws + WS_PROJ), NP, 0, 0};
        pg8::gemm_phase<EpiBf16, SchedInTail>(ring, g, S, E);
        if (!split) { __syncthreads(); p3_relayout(F, F.bid, F.G); }
        else if (!tailer) p3_relayout(F, F.bid - (F.bid >> 2) - 1, 192);
    }
    GRID_BAR();
    }
#endif
#if PH_HI > 4 && PH_LO <= 4
    for (int rep_ = 0; rep_ < ((REP_PHASE == 4) ? 1 + REP_EXTRA : 1); ++rep_) {
    {
        pg8::Gemm g{(const bf16*)(ws + WS_DPOOL), 256, 256};
        SchedPool S{F.G, F.bid, (const char*)(ws + WS_WPOOL)};
        EpiBf16 E{(bf16*)(ws + WS_APOOL), 1024, 0, 256};
        pg8::gemm_phase<EpiBf16, SchedPool>(ring, g, S, E);
    }
    {
        pg8::Gemm g{(const bf16*)(ws + WS_KCG), 3072, 768};
        SchedSplitK S{2, F.G, (F.bid + F.G - 128 % F.G) % F.G, (const char*)(ws + WS_WCK), 3072u, 6144, 768};
        EpiF32 E{(float*)(ws + WS_PARTK), 512, (size_t)2048 * 512};
        pg8::gemm_phase<EpiF32, SchedSplitK>(ring, g, S, E);
    }
    {
        pg8::Gemm g{(const bf16*)(ws + WS_VCG), 2048, 512};
        SchedSplitK S{1, F.G, (F.bid + F.G - 192 % F.G) % F.G, (const char*)(ws + WS_WCV), 2048u, 4096, 512};
        EpiF32 E{(float*)(ws + WS_PARTV), 256, (size_t)2048 * 256};
        pg8::gemm_phase<EpiF32, SchedSplitK>(ring, g, S, E);
    }
    GRID_BAR();
    }
#endif
#if PH_HI > 5 && PH_LO <= 5
    for (int rep_ = 0; rep_ < ((REP_PHASE == 5) ? 1 + REP_EXTRA : 1); ++rep_) {
    p5_cmp2(F);
    __syncthreads();
#ifdef CMP2_TWICE
    p5_cmp2(F);
    __syncthreads();
#endif
#ifdef P5_SPLIT
    TSTAMP();
#endif
    {
        pg8::Gemm g{(const bf16*)(ws + WS_APOOL), 1024, 1024};
        SchedPlain S{32, 8, F.G, F.bid, (const char*)(ws + WS_WPU), 2048u, 2048};
        EpiGate<false> E{(bf16*)(ws + WS_YPART), nullptr, (const bf16*)(ws + WS_PROJ), C_GM};
        pg8::gemm_phase<EpiGate<false>, SchedPlain>(ring, g, S, E);
#ifdef YA_TWICE
        __syncthreads();
        pg8::gemm_phase<EpiGate<false>, SchedPlain>(ring, g, S, E);
#endif
    }
    GRID_BAR();
    }
#endif
#if PH_HI > 6 && PH_LO <= 6
    for (int rep_ = 0; rep_ < ((REP_PHASE == 6) ? 1 + REP_EXTRA : 1); ++rep_) {
    nsa::p6_attention(F);
    GRID_BAR();
    }
#endif
#if defined(DIAG) && DIAG
    diag_attention(F);
    __syncthreads();
    diag_rope_cmp(F);
    GRID_BAR();
#endif
#if PH_HI > 7 && PH_LO <= 7
    for (int rep_ = 0; rep_ < ((REP_PHASE == 7) ? 1 + REP_EXTRA : 1); ++rep_) {
    {
        pg8::Gemm g{(const bf16*)(ws + WS_O), 1024, 1024};
        SchedPlain S{32, 8, F.G, F.bid, (const char*)(ws + WS_WNU), 2048u, 2048};
        EpiGate<true> E{(bf16*)(ws + WS_Y), (const bf16*)(ws + WS_YPART), (const bf16*)(ws + WS_PROJ), C_GM + 2048};
        pg8::gemm_phase<EpiGate<true>, SchedPlain>(ring, g, S, E);
    }
    GRID_BAR();
    }
#endif
#if PH_HI > 8 && PH_LO <= 8
    for (int rep_ = 0; rep_ < ((REP_PHASE == 8) ? 1 + REP_EXTRA : 1); ++rep_) {
    {
        pg8::Gemm g{(const bf16*)(ws + WS_Y), 2048, 2048};
        SchedPlain S{32, 8, F.G, F.bid, (const char*)(ws + WS_WOUT), 4096u, 4096};
        EpiBf16 E{(bf16*)(ws + WS_Z), 2048, 0, 0};
        pg8::gemm_phase<EpiBf16, SchedPlain>(ring, g, S, E);
    }
    GRID_BAR();
    }
#endif
#if PH_HI > 9 && PH_LO <= 9
    for (int rep_ = 0; rep_ < ((REP_PHASE == 9) ? 1 + REP_EXTRA : 1); ++rep_) {
    p9_post_router(F);
    GRID_BAR();
    }
#endif
#if PH_HI > 10 && PH_LO <= 10
    for (int rep_ = 0; rep_ < ((REP_PHASE == 10) ? 1 + REP_EXTRA : 1); ++rep_) {
    __syncthreads();
    conv_pull(F, 1 << 20);
    __syncthreads();
    p10_tables(F);
    GRID_BAR();
    }
#endif
#if PH_HI > 11 && PH_LO <= 11
    for (int rep_ = 0; rep_ < ((REP_PHASE == 11) ? 1 + REP_EXTRA : 1); ++rep_) {
    {
        const LAS int* tile_e = (const LAS int*)(F.lds + LX_TILE_E); const int ntiles = *(const LAS int*)(F.lds + LX_NTILES);
        pg8::Gemm g{(const bf16*)(ws + WS_H2HI), 2048, 2048};
        SchedMoe1 S{F.G, P11_C, ntiles, tile_e, (const int*)(ws + WS_TAB + TB_TOK), (const char*)(ws + WS_W1)};
        EpiMoe1 E{(bf16*)(ws + WS_HID), (const float*)(ws + WS_TAB + TB_WROW)};
        pg8::gemm_phase<EpiMoe1, SchedMoe1>(ring, g, S, E);
    }
    GRID_BAR();
    }
#endif
#if PH_HI > 12 && PH_LO <= 12
    for (int rep_ = 0; rep_ < ((REP_PHASE == 12) ? 1 + REP_EXTRA : 1); ++rep_) {
    {
        const LAS int* tile_e = (const LAS int*)(F.lds + LX_TILE_E); const int ntiles = *(const LAS int*)(F.lds + LX_NTILES);
        pg8::Gemm g{(const bf16*)(ws + WS_HID), 512, 512};
        SchedMoe2 S{F.G, vcu, ntiles, tile_e, (const char*)(ws + WS_W2)};
        EpiBf16 E{(bf16*)(ws + WS_YB), 2048, 0, 0};
        pg8::gemm_phase<EpiBf16, SchedMoe2>(ring, g, S, E);
    }
    GRID_BAR();
    }
#endif
#ifdef EXTRA_BARS
    for (int eb = 0; eb < 10; ++eb) GRID_BAR();
#endif
#if PH_HI > 13 && PH_LO <= 13
    for (int rep_ = 0; rep_ < ((REP_PHASE == 13) ? 1 + REP_EXTRA : 1); ++rep_) {
    p13_final(F);
#if defined(TIMEPH)
    TSTAMP();
    VM_WAIT(); __syncthreads();
    if (F.bid == 0 && F.tid == 0) F.out[4096] = 10.0f + ts_sel * TSCALE;
#endif
#if defined(DIAG) && DIAG
    VM_WAIT(); __syncthreads();
    if (F.bid == 0 && F.tid == 0) {
        const float ad = __builtin_bit_cast(float, __hip_atomic_load(F.ctl + CW_DIAG + 0, RLX_AGENT)), ar = __builtin_bit_cast(float, __hip_atomic_load(F.ctl + CW_DIAG + 1, RLX_AGENT));
        const float rd = __builtin_bit_cast(float, __hip_atomic_load(F.ctl + CW_DIAG + 2, RLX_AGENT));
        const float cd = __builtin_bit_cast(float, __hip_atomic_load(F.ctl + CW_DIAG + 3, RLX_AGENT)), cr = __builtin_bit_cast(float, __hip_atomic_load(F.ctl + CW_DIAG + 4, RLX_AGENT));
        float e = 0.f;
        if (DIAG & 1) e = fmaxf(e, ad);
        if (DIAG & 2) e = fmaxf(e, rd);
        if (DIAG & 4) e = fmaxf(e, cd);
        if (DIAG & 8) e = ar;
        if (DIAG & 16) e = cr;
        asm volatile("s_waitcnt vmcnt(0)" ::: "memory");
        F.out[4096] = 10.0f + 1000.0f * e;
    }
#endif
    }
#endif
}

extern "C" void kernel_launch(void* const* d_in, const int* in_sizes, int n_in, void* d_out, int out_size, void* d_ws, size_t ws_size, hipStream_t stream) {
    static int grid = 0;
    if (grid == 0) {
        if (n_in != 29 || in_sizes[0] != T * D || out_size != T * D || ws_size < WS_END) { fprintf(stderr, "kernel_launch: unexpected shapes (n_in %d, in0 %d, out %d, ws %zu, need %zu)\n", n_in, n_in > 0 ? in_sizes[0] : -1, out_size, ws_size, (size_t)WS_END); grid = -1; return; }
        int dev = 0, cus = 0, per_cu = 0;
        if (hipGetDevice(&dev) != hipSuccess || hipDeviceGetAttribute(&cus, hipDeviceAttributeMultiprocessorCount, dev) != hipSuccess) { grid = -1; return; }
        if (hipFuncSetAttribute((const void*)fwd_kernel, hipFuncAttributeMaxDynamicSharedMemorySize, LDS_BYTES) != hipSuccess) { fprintf(stderr, "kernel_launch: hipFuncSetAttribute failed\n"); grid = -1; return; }
        if (hipOccupancyMaxActiveBlocksPerMultiprocessor(&per_cu, (const void*)fwd_kernel, NWAVES * 64, LDS_BYTES) != hipSuccess || per_cu < 1) { fprintf(stderr, "kernel_launch: occupancy query reports %d\n", per_cu); }
        (void)hipGetLastError();
        grid = cus;
    }
    if (grid < 0) return;
    if (hipMemsetAsync((char*)d_ws + WS_CTL, 0, CTL_ZERO_BYTES, stream) != hipSuccess) return;
    Args a{};
    for (int i = 0; i < 29; ++i) a.in[i] = d_in[i];
    a.out = (float*)d_out; a.ws = (unsigned char*)d_ws;
    hipLaunchKernelGGL(fwd_kernel, dim3(grid), dim3(NWAVES * 64), LDS_BYTES, stream, a);
}
```

```cpp
#include <hip/hip_runtime.h>
#include <cstdio>
#include <cstdint>

namespace pg8 {
#define PG8_LAS __attribute__((address_space(3)))
typedef unsigned short bf16_t;
typedef short bf16x8 __attribute__((ext_vector_type(8)));
typedef float f32x4 __attribute__((ext_vector_type(4)));
typedef float f32x2 __attribute__((ext_vector_type(2)));
typedef unsigned u32x4 __attribute__((ext_vector_type(4)));
typedef unsigned u32x2 __attribute__((ext_vector_type(2)));
constexpr int BM = 256, BK = 64, HALF = 128, HTB = HALF * BK * 2, STAGE_BYTES = 8 * HTB, NXCD = 8, WGM = 8;

__host__ __device__ __forceinline__ int lds_byte(int r, int c) { const int st = (r >> 4) * 2 + (c >> 5), rr = r & 15, cc = c & 31, ob = rr * 64 + cc * 2; return st * 1024 + (ob ^ (((ob >> 9) & 1) << 5)); }
__host__ __device__ __forceinline__ void stage_rc(int b, int& R, int& C) { const int st = b / 1024, sb = b % 1024, swz = sb ^ (((sb >> 9) & 1) << 5); R = (st >> 1) * 16 + swz / 64; C = (st & 1) * 32 + (swz % 64) / 2; }
__host__ __device__ __forceinline__ int perm32(int rho) { const int n = rho >> 4, i = rho & 15; return 8 * (i >> 2) + 4 * n + (i & 3); }

struct Unit { int pm, pn, aux; };
struct Gemm { const bf16_t* A; int ldb, K; };

__device__ __forceinline__ bool static_tile(int i, int G, int c, int nM, int nN, int& pm, int& pn) {
    const int nwg = nM * nN; const long L = (long)i * G + c; if (L >= nwg) return false;
    int wgid = (int)L; { const int q = nwg / NXCD, r = nwg % NXCD, xcd = wgid % NXCD, off = wgid / NXCD; wgid = (xcd < r ? xcd * (q + 1) : r * (q + 1) + (xcd - r) * q) + off; }
    const int nig = WGM * nN, gid = wgid / nig, fm = gid * WGM, gsz = (nM - fm) < WGM ? (nM - fm) : WGM;
    pm = fm + ((wgid % nig) % gsz); pn = (wgid % nig) / gsz; return true;
}
__device__ __forceinline__ unsigned cvt_pk_bf16(float lo, float hi) { unsigned r; asm volatile("v_cvt_pk_bf16_f32 %0, %1, %2" : "=v"(r) : "v"(lo), "v"(hi)); return r; }

template <class Epi, class Sched, bool ALIGN_EPI = true>
__device__ __forceinline__ void gemm_phase(PG8_LAS unsigned char* lds, const Gemm g, const Sched& S, const Epi& E) {
    int tid = threadIdx.x; asm volatile("" : "+v"(tid));
    const int wid = __builtin_amdgcn_readfirstlane(tid >> 6), lane = tid & 63, wr = wid >> 2, wc = wid & 3, fr = lane & 15, fq = lane >> 4;
    const int nt = g.K / BK;
    int Rst[2], Cst[2]; unsigned voffB[2];
#pragma unroll
    for (int i = 0; i < 2; ++i) { int R, C; stage_rc(tid * 16 + i * 8192, R, C); const int Rb = Epi::PERM ? ((R & ~31) + perm32(R & 31)) : R;
        Rst[i] = R; Cst[i] = C; voffB[i] = (unsigned)(Rb * g.ldb + C) * 2u; }
    const unsigned kstep = (unsigned)(BK * 2);
    const size_t hstepB = (size_t)HALF * g.ldb * 2;
    const unsigned ldsw = (unsigned)wid * 1024u;
    const int aoff = lds_byte(wr * 64 + fr, fq * 8), boff = lds_byte(wc * 32 + fr, fq * 8);
    const char* Ab = (const char*)g.A;
#define PG8_SA(b, h) (((b) * 2 + (h)) * HTB)
#define PG8_SB(b, h) ((4 + (b) * 2 + (h)) * HTB)
#define PG8_STAGEB(bufoff, gbase) do { _Pragma("unroll") for (int _i = 0; _i < 2; ++_i) \
        __builtin_amdgcn_global_load_lds((const unsigned*)((const char*)(gbase) + voffB[_i]), (PG8_LAS unsigned*)(lds + (bufoff) + ldsw + _i * 8192), 16, 0, 0); } while (0)
#define PG8_STAGEA(bufoff, vo0, vo1, kb) do { \
        __builtin_amdgcn_global_load_lds((const unsigned*)(Ab + (size_t)(vo0) + (kb)), (PG8_LAS unsigned*)(lds + (bufoff) + ldsw), 16, 0, 0); \
        __builtin_amdgcn_global_load_lds((const unsigned*)(Ab + (size_t)(vo1) + (kb)), (PG8_LAS unsigned*)(lds + (bufoff) + ldsw + 8192), 16, 0, 0); } while (0)
#define PG8_LDA(dst, b, h) do { _Pragma("unroll") for (int m = 0; m < 4; ++m) _Pragma("unroll") for (int k = 0; k < 2; ++k) dst[m][k] = *(const PG8_LAS bf16x8*)(lds + PG8_SA(b, h) + aoff + m * 2048 + k * 1024); } while (0)
#define PG8_LDB(dst, b, h) do { _Pragma("unroll") for (int n = 0; n < 2; ++n) _Pragma("unroll") for (int k = 0; k < 2; ++k) dst[n][k] = *(const PG8_LAS bf16x8*)(lds + PG8_SB(b, h) + boff + n * 2048 + k * 1024); } while (0)
#if defined(ABL_GEMM)
#define PG8_MMA(ai, bj, At, Bt) do { asm volatile("" :: "v"(At[0][0]), "v"(Bt[0][0])); } while (0)
#else
#define PG8_MMA(ai, bj, At, Bt) do { __builtin_amdgcn_s_setprio(1); _Pragma("unroll") for (int m = 0; m < 4; ++m) _Pragma("unroll") for (int n = 0; n < 2; ++n) _Pragma("unroll") for (int k = 0; k < 2; ++k) \
        acc[ai][bj][m][n] = __builtin_amdgcn_mfma_f32_16x16x32_bf16(Bt[n][k], At[m][k], acc[ai][bj][m][n], 0, 0, 0); __builtin_amdgcn_s_setprio(0); } while (0)
#endif
#define PG8_WAIT_V(n) asm volatile("s_waitcnt vmcnt(" #n ")" ::: "memory")
#define PG8_WAIT_L(n) asm volatile("s_waitcnt lgkmcnt(" #n ")" ::: "memory")
#define PG8_BAR __builtin_amdgcn_s_barrier()
#define PG8_SCHED __builtin_amdgcn_sched_barrier(0)
    Unit cur, nxt; int ui = 0;
    if (!S.next(0, cur)) return;
    f32x4 acc[2][2][4][2];
#pragma unroll
    for (int a = 0; a < 2; ++a)
#pragma unroll
        for (int b = 0; b < 2; ++b)
#pragma unroll
            for (int m = 0; m < 4; ++m)
#pragma unroll
                for (int n = 0; n < 2; ++n) acc[a][b][m][n] = (f32x4){0.f, 0.f, 0.f, 0.f};
    bf16x8 At[4][2], B0[2][2], B1[2][2];
    unsigned c00, c01, c10, c11, n00, n01, n10, n11;
    c00 = S.aoff(cur, Rst[0]) + (unsigned)Cst[0] * 2u; c01 = S.aoff(cur, Rst[1]) + (unsigned)Cst[1] * 2u;
    c10 = S.aoff(cur, HALF + Rst[0]) + (unsigned)Cst[0] * 2u; c11 = S.aoff(cur, HALF + Rst[1]) + (unsigned)Cst[1] * 2u;
    const char* cB = S.bptr(cur);
    PG8_WAIT_V(0);
    PG8_STAGEB(PG8_SB(0, 0), cB); PG8_STAGEB(PG8_SB(0, 1), cB + hstepB); PG8_STAGEA(PG8_SA(0, 0), c00, c01, 0u); PG8_STAGEA(PG8_SA(0, 1), c10, c11, 0u);
    if (wr == 1) PG8_BAR;
    PG8_WAIT_V(2); PG8_BAR;
    PG8_STAGEB(PG8_SB(1, 0), cB + kstep); PG8_STAGEA(PG8_SA(1, 0), c00, c01, kstep); PG8_STAGEB(PG8_SB(1, 1), cB + hstepB + kstep);
    PG8_WAIT_V(6); PG8_BAR;
    for (;;) {
        const bool has_next = S.next(ui + 1, nxt);
        const char* nB = cB; n00 = c00; n01 = c01; n10 = c10; n11 = c11;
        if (has_next) {
            nB = S.bptr(nxt);
            n00 = S.aoff(nxt, Rst[0]) + (unsigned)Cst[0] * 2u; n01 = S.aoff(nxt, Rst[1]) + (unsigned)Cst[1] * 2u;
            n10 = S.aoff(nxt, HALF + Rst[0]) + (unsigned)Cst[0] * 2u; n11 = S.aoff(nxt, HALF + Rst[1]) + (unsigned)Cst[1] * 2u;
        }
#pragma nounroll
        for (int t = 0; t < nt; t += 2) {
            const bool last = (t == nt - 2);
            const unsigned k1 = (unsigned)(t + 1) * kstep;
            const unsigned k2 = last ? 0u : (unsigned)(t + 2) * kstep, k3 = k2 + kstep;
            const char* b2 = last ? nB : cB;
            const unsigned a00 = last ? n00 : c00, a01 = last ? n01 : c01, a10 = last ? n10 : c10, a11 = last ? n11 : c11;
            PG8_LDB(B0, 0, 0); PG8_LDB(B1, 0, 1); PG8_SCHED; PG8_LDA(At, 0, 0); PG8_STAGEA(PG8_SA(1, 1), c10, c11, k1);
            PG8_WAIT_V(8); PG8_WAIT_L(0); PG8_BAR; PG8_MMA(0, 0, At, B0); PG8_MMA(0, 1, At, B1); PG8_BAR; PG8_SCHED;
            PG8_LDA(At, 0, 1); PG8_STAGEB(PG8_SB(0, 0), b2 + k2); PG8_STAGEB(PG8_SB(0, 1), b2 + hstepB + k2); PG8_STAGEA(PG8_SA(0, 0), a00, a01, k2);
            PG8_WAIT_V(8); PG8_WAIT_L(0); PG8_BAR; PG8_MMA(1, 0, At, B0); PG8_MMA(1, 1, At, B1); PG8_BAR; PG8_SCHED;
            PG8_LDB(B0, 1, 0); PG8_LDB(B1, 1, 1); PG8_SCHED; PG8_LDA(At, 1, 0); PG8_STAGEA(PG8_SA(0, 1), a10, a11, k2);
            PG8_WAIT_V(8); PG8_WAIT_L(0); PG8_BAR; PG8_MMA(0, 0, At, B0); PG8_MMA(0, 1, At, B1); PG8_BAR; PG8_SCHED;
            PG8_LDA(At, 1, 1); PG8_STAGEB(PG8_SB(1, 0), b2 + k3); PG8_STAGEB(PG8_SB(1, 1), b2 + hstepB + k3); PG8_STAGEA(PG8_SA(1, 0), a00, a01, k3);
            PG8_WAIT_V(8); PG8_WAIT_L(0); PG8_BAR; PG8_MMA(1, 0, At, B0); PG8_MMA(1, 1, At, B1); PG8_BAR; PG8_SCHED;
        }
        if constexpr (ALIGN_EPI) { if (wr == 0) PG8_BAR; }
        E(acc, cur, wr, wc, fr, fq);
        if (!has_next) break;
#pragma unroll
        for (int a = 0; a < 2; ++a)
#pragma unroll
            for (int b = 0; b < 2; ++b)
#pragma unroll
                for (int m = 0; m < 4; ++m)
#pragma unroll
                    for (int n = 0; n < 2; ++n) acc[a][b][m][n] = (f32x4){0.f, 0.f, 0.f, 0.f};
        cur = nxt; cB = nB; c00 = n00; c01 = n01; c10 = n10; c11 = n11; ++ui;
        if constexpr (ALIGN_EPI) { if (wr == 1) PG8_BAR; }
    }
    PG8_WAIT_V(0);
    if constexpr (!ALIGN_EPI) { if (wr == 0) PG8_BAR; }
    PG8_BAR;
#undef PG8_SA
#undef PG8_SB
#undef PG8_STAGEA
#undef PG8_STAGEB
#undef PG8_LDA
#undef PG8_LDB
#undef PG8_MMA
#undef PG8_WAIT_V
#undef PG8_WAIT_L
#undef PG8_BAR
#undef PG8_SCHED
}
}
#ifndef PH_HI
#define PH_HI 14
#endif
#define REP_PHASE -1
#define REP_EXTRA 1
#define CONV_P0 (1 << 20)
#define CONV_P2 0
#define P11_C F.bid
#ifndef PH_LO
#define PH_LO 0
#endif
constexpr int T = 8192, D = 2048;
constexpr int NP = 8704;
constexpr int IN_COLS = 8624;
constexpr int C_U = 0, C_Q = 1024, C_KC = 2560, C_VC = 2944, C_KS = 3200, C_VS = 3584, C_KW = 3840, C_VW = 4224, C_GN = 4480, C_GM = 4528;
constexpr int NH = 16, NG = 4, DQK = 96, DV = 64, ROT = 24, HALFROT = 12;
constexpr int NCMP = 511, NCMPP = 512, NSLC = 128, NSEL = 16, WIN = 512;
constexpr int NE = 64, NE1 = 65, TOPK = 8, DE = 512;
constexpr int MAXTILES = 352;
constexpr float RMS_EPS = 1e-6f;
constexpr int NWAVES = 8;

constexpr size_t MiB = 1u << 20;
constexpr size_t WS_CTL = 0, CTL_ZERO_BYTES = 32768;
constexpr size_t WS_WIN = 1 * MiB;
constexpr size_t WS_WOUT = 35 * MiB;
constexpr size_t WS_WPU = 43 * MiB;
constexpr size_t WS_WNU = 47 * MiB;
constexpr size_t WS_WCK = 51 * MiB;
constexpr size_t WS_WCV = 54 * MiB;
constexpr size_t WS_WPOOL = 55 * MiB;
constexpr size_t WS_WRT = 55 * MiB + 512 * 1024;
constexpr size_t WS_W1 = 56 * MiB;
constexpr size_t WS_W2 = 316 * MiB;
constexpr size_t WS_SMALL = 446 * MiB;
constexpr size_t SM_MOD = 0;
constexpr size_t SM_BIASK = 65536;
constexpr size_t SM_BIASV = 65536 + 2048;
constexpr size_t SM_ROPE = 131072;
constexpr size_t SM_END = 131072 + 786432;
constexpr size_t SM_KNS = SM_END + 4096;
constexpr size_t SM_KNW = SM_KNS + 4096;
constexpr size_t SM_KNC = SM_KNW + 4096;
constexpr size_t WS_ACT = 448 * MiB;
constexpr size_t WS_X1 = WS_ACT;
constexpr size_t WS_H2HI = WS_ACT + 64 * MiB;
constexpr size_t WS_H2LO = WS_ACT + 96 * MiB;
constexpr size_t WS_OV = WS_ACT + 128 * MiB;
constexpr size_t WS_HID = WS_OV;
constexpr size_t WS_YB = WS_OV + 88 * MiB;
constexpr size_t WS_PROJ = WS_OV;
constexpr size_t WS_QR = WS_OV + 136 * MiB;
constexpr size_t WS_KSG = WS_OV + 160 * MiB;
constexpr size_t WS_KWG = WS_OV + 166 * MiB;
constexpr size_t WS_KCG = WS_OV + 172 * MiB;
constexpr size_t WS_VCG = WS_OV + 179 * MiB;
constexpr size_t WS_VST = WS_OV + 184 * MiB;
constexpr size_t WS_VWT = WS_OV + 188 * MiB;
constexpr size_t WS_DPOOL = WS_OV + 192 * MiB;
constexpr size_t WS_APOOL = WS_OV + 208 * MiB;
constexpr size_t WS_PARTK = WS_OV + 224 * MiB;
constexpr size_t WS_PARTV = WS_OV + 240 * MiB;
constexpr size_t WS_KCR = WS_OV + 248 * MiB;
constexpr size_t WS_VCT = WS_OV + 248 * MiB + 512 * 1024;
constexpr size_t WS_YPART = WS_OV + 249 * MiB;
constexpr size_t WS_O = WS_OV + 281 * MiB;
constexpr size_t WS_Y = WS_OV + 297 * MiB;
constexpr size_t WS_Z = WS_OV + 329 * MiB;
constexpr size_t WS_H = WS_OV + 393 * MiB;
constexpr size_t WS_TAB = WS_OV + 440 * MiB;
constexpr size_t TB_SELE = 0;
constexpr size_t TB_SELW = 262144;
constexpr size_t TB_SELR = 524288;
constexpr size_t TB_POS = 786432;
constexpr size_t TB_TOK = 1048576;
constexpr size_t TB_WROW = 1048576 + 524288;
constexpr size_t WS_END = WS_TAB + 4 * MiB;
static_assert(WS_END <= 1024 * MiB, "ws map");
static_assert(WS_YB + (size_t)MAXTILES * 256 * 2048 * 2 <= WS_TAB, "YB");
constexpr int CW_BAR = 0;
constexpr int CW_CNT = 4096;

constexpr int RING_OFF = 0, RING_BYTES = 131072;
constexpr int LDSCTL_OFF = RING_BYTES, MISC_OFF = LDSCTL_OFF + 320;
constexpr int LDS_BYTES = 147456;
constexpr int LDS_X = MISC_OFF + 128;

#define GAS __attribute__((address_space(1)))
#define LAS __attribute__((address_space(3)))
typedef unsigned short bf16;
typedef unsigned v4u __attribute__((ext_vector_type(4)));
typedef unsigned v2u __attribute__((ext_vector_type(2)));
typedef float f32x4 __attribute__((ext_vector_type(4)));
typedef float f32x16 __attribute__((ext_vector_type(16)));
typedef short bf16x8 __attribute__((ext_vector_type(8)));
typedef short s16x4 __attribute__((ext_vector_type(4)));
typedef GAS unsigned gu32;
#define RLX_AGENT __ATOMIC_RELAXED, __HIP_MEMORY_SCOPE_AGENT
#define LDS_WAIT() asm volatile("s_waitcnt lgkmcnt(0)" ::: "memory")
#define VM_WAIT() asm volatile("s_waitcnt vmcnt(0)" ::: "memory")
__device__ __forceinline__ unsigned f2bf(float f) { unsigned u = __builtin_bit_cast(unsigned, f); return (u + 0x7fffu + ((u >> 16) & 1u)) >> 16; }
__device__ __forceinline__ unsigned pk2(float lo, float hi) { return f2bf(lo) | (f2bf(hi) << 16); }
__device__ __forceinline__ float bf2f(unsigned b) { return __builtin_bit_cast(float, b << 16); }
__device__ __forceinline__ float bflo(unsigned w) { return __builtin_bit_cast(float, w << 16); }
__device__ __forceinline__ float bfhi(unsigned w) { return __builtin_bit_cast(float, w & 0xffff0000u); }
__device__ __forceinline__ float sigmoidf_(float v) { return 1.0f / (1.0f + __expf(-v)); }

#define XB_TMO      128
#define XB_XCNT(j)  (256  + 64 * (j))
#define XB_XSUB(j)  (1280 + 64 * (j))
#define XB_XGEN(j)  (2304 + 64 * (j))
#define XB_TOP      3328
#define XB_TOPGEN   3392
#define XCD_BAR_WORDS 3456
#define XB_SPIN_CAP (1u << 18)
__device__ __forceinline__ unsigned xb_ld(unsigned* p)              { return __hip_atomic_load(p, __ATOMIC_RELAXED, __HIP_MEMORY_SCOPE_AGENT); }
__device__ __forceinline__ unsigned xb_add(unsigned* p, unsigned v) { return __hip_atomic_fetch_add(p, v, __ATOMIC_RELAXED, __HIP_MEMORY_SCOPE_AGENT); }
__device__ __forceinline__ unsigned xb_xcc_id() { return (unsigned)__builtin_amdgcn_s_getreg((3 << 11) | 20) & 0xFu; }
#define XB_SPIN(cond, bar) do { unsigned _sp = 0; while (cond) { __builtin_amdgcn_s_sleep(1); \
    if ((++_sp & 255u) == 0u) { if (xb_ld(&(bar)[XB_TMO])) break; if (_sp > XB_SPIN_CAP) { atomicAdd(&(bar)[XB_TMO], 1u); break; } } } } while (0)
struct XcdBarrier { unsigned* bar; unsigned x; volatile LAS unsigned* st; };
__device__ __forceinline__ XcdBarrier xcd_barrier_post(unsigned* bar, volatile LAS unsigned* st) {
    XcdBarrier b; b.bar = bar; b.x = xb_xcc_id(); b.st = st;
    if (threadIdx.x == 0) (void)xb_add(&bar[XB_XCNT(b.x)], 1u);
    return b;
}
__device__ __forceinline__ void xcd_barrier_complete(unsigned* bar, unsigned x, unsigned& nloc, unsigned& nx) {
    const unsigned G = gridDim.x * gridDim.y * gridDim.z;
    unsigned sum, cnt, mine, sp = 0u;
    for (;;) {
        sum = 0u; cnt = 0u; mine = 0u;
#pragma unroll
        for (unsigned j = 0; j < 16; ++j) { const unsigned c = xb_ld(&bar[XB_XCNT(j)]); sum += c; cnt += (c > 0u) ? 1u : 0u; mine = (j == x) ? c : mine; }
        if (sum == G) break;
        __builtin_amdgcn_s_sleep(1);
        if ((++sp & 255u) == 0u) { if (xb_ld(&bar[XB_TMO])) break; if (sp > XB_SPIN_CAP) { atomicAdd(&bar[XB_TMO], 1u); break; } }
    }
    nloc = mine > 0u ? mine : 1u; nx = cnt > 0u ? cnt : 1u;
}
__device__ __forceinline__ void xcd_barrier(const XcdBarrier& b) {
    asm volatile("s_waitcnt vmcnt(0)" ::: "memory");
    __syncthreads();
    if (threadIdx.x == 0) {
        unsigned* bar = b.bar;
        __builtin_amdgcn_s_waitcnt(0);
        unsigned nloc = b.st[0], nx = b.st[1];
        if (nloc == 0u) { xcd_barrier_complete(bar, b.x, nloc, nx); b.st[0] = nloc; b.st[1] = nx; }
        const unsigned old = xb_add(&bar[XB_XSUB(b.x)], 1u);
        const unsigned gen = old / nloc;
        if (old + 1u == (gen + 1u) * nloc) {
            __builtin_amdgcn_fence(__ATOMIC_RELEASE, "agent");
            asm volatile("s_waitcnt vmcnt(0)" ::: "memory");
            const unsigned og = xb_add(&bar[XB_TOP], 1u);
            const unsigned tg = og / nx;
            if (og + 1u == (tg + 1u) * nx) xb_add(&bar[XB_TOPGEN], 1u);
            else XB_SPIN(xb_ld(&bar[XB_TOPGEN]) == tg, bar);
            __builtin_amdgcn_fence(__ATOMIC_ACQUIRE, "agent");
            xb_add(&bar[XB_XGEN(b.x)], 1u);
            asm volatile("s_waitcnt vmcnt(0)" ::: "memory");
        } else {
            XB_SPIN(xb_ld(&bar[XB_XGEN(b.x)]) == gen, bar);
            __builtin_amdgcn_fence(__ATOMIC_ACQUIRE, "agent");
            asm volatile("s_waitcnt vmcnt(0)" ::: "memory");
        }
    }
    __syncthreads();
}

__device__ __forceinline__ float wave_sum(float v) {
#pragma unroll
    for (int o = 1; o < 64; o <<= 1) v += __shfl_xor(v, o);
    return v;
}
struct Frame {
    LAS unsigned char* lds;
    volatile LAS unsigned* MISC;
    gu32* ctl;
    unsigned char* ws;
    int tid, lane, wave, G, bid;
    const float *x, *c; const int* positions;
    const float *w_ada, *b_ada, *g_pre_mix, *g_post_mix, *g_pre_ffn, *g_post_ffn, *w_in;
    const float *cmp_pos_k, *cmp_k_w1, *cmp_k_w2, *cmp_pos_v, *cmp_v_w1, *cmp_v_w2, *pool_w, *pool_scale;
    const float *w_pool_up, *w_nsa_up, *w_out, *w_router, *router_bias, *w_exp_gate, *w_exp_up, *w_exp_down, *w_sh_gate, *w_sh_up, *w_sh_down;
    float* out;
};

__device__ __forceinline__ void transpose_item(const float* W, int ldw, int nvalid, bf16* WT, int ldt, int k0, int n0, int dst_row0, const float* scale, LAS float* scr, int lane) {
    const int nn = n0 + (lane & 31); const bool ok = nn < nvalid;
    const float sc = (scale && ok) ? scale[nn] : 1.0f;
    float v[32];
#pragma unroll
    for (int i = 0; i < 32; ++i) { const int kk = 2 * i + (lane >> 5); v[i] = ok ? W[(size_t)(k0 + kk) * ldw + nn] : 0.f; }
#pragma unroll
    for (int i = 0; i < 32; ++i) { const int kk = 2 * i + (lane >> 5); scr[kk * 33 + (lane & 31)] = v[i] * sc; }
    LDS_WAIT(); asm volatile("" ::: "memory");
    const int c = lane & 7;
#pragma unroll
    for (int j = 0; j < 4; ++j) { const int n = (lane >> 3) + 8 * j; const LAS float* s = scr + (8 * c) * 33 + n;
        v4u o; o.x = pk2(s[0 * 33], s[1 * 33]); o.y = pk2(s[2 * 33], s[3 * 33]); o.z = pk2(s[4 * 33], s[5 * 33]); o.w = pk2(s[6 * 33], s[7 * 33]);
        *(GAS v4u*)(WT + (size_t)(dst_row0 + n) * ldt + k0 + 8 * c) = o; }
    LDS_WAIT(); asm volatile("" ::: "memory");
}
__device__ __forceinline__ void tr_job(const float* W, int K, int N, int nvalid, bf16* WT, int it, LAS float* scr, int lane) {
    const int nblk = N / 32, kb = it / nblk, nb = it % nblk;
    transpose_item(W, nvalid, nvalid, WT, K, 64 * kb, 32 * nb, 32 * nb, nullptr, scr, lane);
}

template <bool SILU>
__device__ __forceinline__ void gemv64(Frame& F, const float* vec, const float* W, int ldw, int K, int col0, const float* addend, float* out) {
    LAS float* red = (LAS float*)(F.lds + RING_OFF);
    const int rsub = F.lane >> 4, c4 = F.lane & 15;
    const int kper = K / NWAVES, kbeg = F.wave * kper;
    f32x4 acc = (f32x4){0.f, 0.f, 0.f, 0.f};
#pragma unroll 8
    for (int k = kbeg + rsub; k < kbeg + kper; k += 4) {
        float v = vec[k]; if (SILU) v = v / (1.0f + __expf(-v));
        const f32x4 w = *(const GAS f32x4*)(W + (size_t)k * ldw + col0 + 4 * c4);
        acc += w * v;
    }
#pragma unroll
    for (int j = 0; j < 4; ++j) { acc[j] += __shfl_xor(acc[j], 16); acc[j] += __shfl_xor(acc[j], 32); }
    __syncthreads();
    if (rsub == 0) { red[F.wave * 64 + 4 * c4 + 0] = acc[0]; red[F.wave * 64 + 4 * c4 + 1] = acc[1]; red[F.wave * 64 + 4 * c4 + 2] = acc[2]; red[F.wave * 64 + 4 * c4 + 3] = acc[3]; }
    __syncthreads();
    if (F.tid < 64) { float s = addend ? addend[col0 + F.tid] : 0.f;
#pragma unroll
        for (int w = 0; w < NWAVES; ++w) s += red[w * 64 + F.tid];
        out[col0 + F.tid] = s; }
    __syncthreads();
}

__device__ __forceinline__ void p0_prologue(Frame& F) {
    unsigned char* ws = F.ws;
    float* small = (float*)(ws + WS_SMALL);
    if (F.bid < 192) gemv64<true>(F, F.c, F.w_ada, 6 * D, D, 64 * F.bid, F.b_ada, small + SM_MOD / 4);
    else if (F.bid < 198) gemv64<false>(F, F.cmp_pos_k, F.cmp_k_w1, 384, 3072, 64 * (F.bid - 192), nullptr, small + SM_BIASK / 4);
    else if (F.bid < 202) gemv64<false>(F, F.cmp_pos_v, F.cmp_v_w1, 256, 2048, 64 * (F.bid - 198), nullptr, small + SM_BIASV / 4);
    {
        const float inv[12] = {1.000000000e+00f, 3.350316475e-01f, 1.122462048e-01f, 3.760603093e-02f, 1.259921050e-02f, 4.221134251e-03f, 1.414213562e-03f, 4.738062997e-04f, 1.587401052e-04f, 5.318295897e-05f, 1.781797436e-05f, 5.969585306e-06f};
        float* rope = small + SM_ROPE / 4;
        const int gt = F.bid * 512 + F.tid, NT = F.G * 512;
        for (int idx = gt; idx < T * 12; idx += NT) {
            const int t = idx / 12, i = idx % 12;
            float iv = inv[0];
#pragma unroll
            for (int q = 1; q < 12; ++q) iv = (i == q) ? inv[q] : iv;
            const float ang = (float)F.positions[t] * iv;
            const float kf = rintf(ang * 0.15915494309189535f);
            float r = fmaf(-kf, 6.2831855f, ang); r = fmaf(-kf, -1.7484555e-07f, r);
            rope[t * 24 + i] = __cosf(r); rope[t * 24 + 12 + i] = __sinf(r);
        }
        bf16* wr_hi = (bf16*)(ws + WS_WRT); bf16* wr_lo = wr_hi + 64 * 2048;
        for (int idx = gt; idx < 64 * 2048; idx += NT) {
            const int e = idx & 63, d = idx >> 6;
            const float v = F.w_router[idx];
            const unsigned h = f2bf(v); const float lo = v - bf2f(h);
            wr_hi[e * 2048 + d] = (bf16)h; wr_lo[e * 2048 + d] = (bf16)f2bf(lo);
        }
    }
    LAS float* scr = (LAS float*)(F.lds + RING_OFF + 4096 + F.wave * 8704);
    const int gw = F.bid * NWAVES + F.wave, NGW = F.G * NWAVES;
    constexpr int I_IN = 32 * 272, I_POOL = 4 * 4 * 8, I_CK = 48 * 16, I_CV = 32 * 8, I_PU = 16 * 64, I_NU = 16 * 64, I_OUT = 32 * 64;
    constexpr int NITEMS = I_IN + I_POOL + I_CK + I_CV + I_PU + I_NU + I_OUT;
    for (int it = gw; it < NITEMS; it += NGW) {
        int r = it;
        if (r < I_IN) { tr_job(F.w_in, 2048, NP, IN_COLS, (bf16*)(ws + WS_WIN), r, scr, F.lane); continue; } r -= I_IN;
        if (r < I_POOL) { const int g = r / 32, q = r % 32, kb = q / 8, nb = q % 8;
            transpose_item(F.pool_w + (size_t)g * 65536, 256, 256, (bf16*)(ws + WS_WPOOL) + (size_t)g * 65536, 256, 64 * kb, 32 * nb, 32 * nb, F.pool_scale + g * 256, scr, F.lane); continue; } r -= I_POOL;
        if (r < I_CK) { tr_job(F.cmp_k_w1, 3072, 512, 384, (bf16*)(ws + WS_WCK), r, scr, F.lane); continue; } r -= I_CK;
        if (r < I_CV) { tr_job(F.cmp_v_w1, 2048, 256, 256, (bf16*)(ws + WS_WCV), r, scr, F.lane); continue; } r -= I_CV;
        if (r < I_PU) { tr_job(F.w_pool_up, 1024, 2048, 2048, (bf16*)(ws + WS_WPU), r, scr, F.lane); continue; } r -= I_PU;
        if (r < I_NU) { tr_job(F.w_nsa_up, 1024, 2048, 2048, (bf16*)(ws + WS_WNU), r, scr, F.lane); continue; } r -= I_NU;
        tr_job(F.w_out, 2048, 2048, 2048, (bf16*)(ws + WS_WOUT), r, scr, F.lane);
    }
}

constexpr int MOE_I_E1 = 32 * 16, MOE_I_E2 = 8 * 64;
constexpr int MOE_I_G = NE1 * MOE_I_E1, MOE_I_U = NE1 * MOE_I_E1, MOE_I_D = NE1 * MOE_I_E2;
constexpr int MOE_ITEMS = MOE_I_G + MOE_I_U + MOE_I_D, MOE_BATCH = 32, MOE_NBATCH = MOE_ITEMS / MOE_BATCH;
static_assert(MOE_ITEMS % MOE_BATCH == 0, "batches");
constexpr int CW_CONV = 4608;
__device__ __forceinline__ void moe_item(Frame& F, int r, LAS float* scr) {
    unsigned char* ws = F.ws;
    if (r < MOE_I_G + MOE_I_U) {
        const int s = r >= MOE_I_G ? 1 : 0; if (s) r -= MOE_I_G;
        const int e = r / MOE_I_E1, q = r % MOE_I_E1, kb = q / 16, nb = q % 16, n0 = 32 * nb;
        const float* src = (e < NE) ? ((s ? F.w_exp_up : F.w_exp_gate) + (size_t)e * 2048 * 512) : (s ? F.w_sh_up : F.w_sh_gate);
        transpose_item(src, 512, 512, (bf16*)(ws + WS_W1) + (size_t)e * 1024 * 2048, 2048, 64 * kb, n0, 256 * (n0 >> 7) + 128 * s + (n0 & 127), nullptr, scr, F.lane); return; }
    r -= MOE_I_G + MOE_I_U;
    { const int e = r / MOE_I_E2, q = r % MOE_I_E2, kb = q / 64, nb = q % 64;
      const float* src = (e < NE) ? (F.w_exp_down + (size_t)e * 512 * 2048) : F.w_sh_down;
      transpose_item(src, 2048, 2048, (bf16*)(ws + WS_W2) + (size_t)e * 2048 * 512, 512, 64 * kb, 32 * nb, 32 * nb, nullptr, scr, F.lane); }
}
__device__ __forceinline__ bool conv_pull(Frame& F, int max_batches) {
    LAS float* scr = (LAS float*)(F.lds + RING_OFF + 4096 + F.wave * 8704);
    volatile LAS unsigned* slot = F.MISC + 16;
    if (max_batches <= 0) return true;
    unsigned nxt = 0u;
    if (F.tid == 0) nxt = __hip_atomic_fetch_add((unsigned*)(F.ctl + CW_CONV), 1u, __ATOMIC_RELAXED, __HIP_MEMORY_SCOPE_AGENT);
    for (int n = 0; n < max_batches; ++n) {
        if (F.tid == 0) *slot = nxt;
        __syncthreads();
        const int b = (int)*slot;
        __syncthreads();
        if (b >= MOE_NBATCH) return false;
        if (F.tid == 0 && n + 1 < max_batches) nxt = __hip_atomic_fetch_add((unsigned*)(F.ctl + CW_CONV), 1u, __ATOMIC_RELAXED, __HIP_MEMORY_SCOPE_AGENT);
#pragma nounroll
        for (int q = 0; q < 4; ++q) moe_item(F, b * MOE_BATCH + 4 * F.wave + q, scr);
    }
    return true;
}
__device__ __forceinline__ void p1_norm(Frame& F) {
    const float* mod = (const float*)(F.ws + WS_SMALL + SM_MOD);
    bf16* H = (bf16*)(F.ws + WS_H);
    const int gw = F.bid * NWAVES + F.wave, NGW = F.G * NWAVES, lane = F.lane;
    for (int row = gw; row < T; row += 2 * NGW) {
        const int row2 = row + NGW; const bool two = row2 < T;
        const GAS f32x4* xa = (const GAS f32x4*)(F.x + (size_t)row * D) + lane;
        const GAS f32x4* xb = (const GAS f32x4*)(F.x + (size_t)(two ? row2 : row) * D) + lane;
        f32x4 va[8], vb[8];
#pragma unroll
        for (int j = 0; j < 8; ++j) { va[j] = xa[64 * j]; vb[j] = xb[64 * j]; }
        float sa = 0.f, sb = 0.f;
#pragma unroll
        for (int j = 0; j < 8; ++j) { sa += (va[j].x * va[j].x + va[j].y * va[j].y) + (va[j].z * va[j].z + va[j].w * va[j].w); sb += (vb[j].x * vb[j].x + vb[j].y * vb[j].y) + (vb[j].z * vb[j].z + vb[j].w * vb[j].w); }
        const float ra = 1.0f / sqrtf(wave_sum(sa) * (1.0f / D) + RMS_EPS), rb = 1.0f / sqrtf(wave_sum(sb) * (1.0f / D) + RMS_EPS);
        GAS v2u* oa = (GAS v2u*)(H + (size_t)row * D) + lane; GAS v2u* ob = (GAS v2u*)(H + (size_t)row2 * D) + lane;
#pragma unroll
        for (int j = 0; j < 8; ++j) {
            const int col = 4 * (lane + 64 * j);
            const f32x4 g = *(const GAS f32x4*)(F.g_pre_mix + col), sh = *(const GAS f32x4*)(mod + col), sc = *(const GAS f32x4*)(mod + D + col);
            const f32x4 gs = g * (sc + 1.0f);
            const f32x4 ha = (va[j] * ra) * gs + sh, hb = (vb[j] * rb) * gs + sh;
            v2u o; o.x = pk2(ha.x, ha.y); o.y = pk2(ha.z, ha.w); oa[64 * j] = o;
            if (two) { v2u p; p.x = pk2(hb.x, hb.y); p.y = pk2(hb.z, hb.w); ob[64 * j] = p; }
        }
    }
}

__device__ __forceinline__ void unpack8(const v4u w, float (&f)[8]) { f[0] = bflo(w.x); f[1] = bfhi(w.x); f[2] = bflo(w.y); f[3] = bfhi(w.y); f[4] = bflo(w.z); f[5] = bfhi(w.z); f[6] = bflo(w.w); f[7] = bfhi(w.w); }
__device__ __forceinline__ v4u pack8(const float (&f)[8]) { v4u o; o.x = pk2(f[0], f[1]); o.y = pk2(f[2], f[3]); o.z = pk2(f[4], f[5]); o.w = pk2(f[6], f[7]); return o; }

__device__ __forceinline__ void rope24(const bf16* src, bf16* dst, const float* cs, float scale) {
    float v[24];
    { float a[8]; unpack8(*(const GAS v4u*)(src), a);
#pragma unroll
      for (int i = 0; i < 8; ++i) v[i] = a[i];
      unpack8(*(const GAS v4u*)(src + 8), a);
#pragma unroll
      for (int i = 0; i < 8; ++i) v[8 + i] = a[i];
      unpack8(*(const GAS v4u*)(src + 16), a);
#pragma unroll
      for (int i = 0; i < 8; ++i) v[16 + i] = a[i]; }
    float o[24];
#pragma unroll
    for (int i = 0; i < 12; ++i) { const float c = cs[i], s = cs[12 + i]; o[i] = (v[i] * c - v[12 + i] * s) * scale; o[12 + i] = (v[12 + i] * c + v[i] * s) * scale; }
    float a[8];
#pragma unroll
    for (int i = 0; i < 8; ++i) a[i] = o[i];
    *(GAS v4u*)(dst) = pack8(a);
#pragma unroll
    for (int i = 0; i < 8; ++i) a[i] = o[8 + i];
    *(GAS v4u*)(dst + 8) = pack8(a);
#pragma unroll
    for (int i = 0; i < 8; ++i) a[i] = o[16 + i];
    *(GAS v4u*)(dst + 16) = pack8(a);
}
template <bool ROPE>
__device__ __forceinline__ void seg96(const bf16* src, int nheads, bf16* dbase, size_t hstride, const float* cs, float scale, int lane) {
    const int nch = nheads * 12;
    for (int ci = lane; ci < nch; ci += 64) {
        const int head = ci / 12, kk = ci % 12;
        if (ROPE && kk < 3) continue;
        float a[8]; unpack8(*(const GAS v4u*)(src + ci * 8), a);
#pragma unroll
        for (int i = 0; i < 8; ++i) a[i] *= scale;
        *(GAS v4u*)(dbase + (size_t)head * hstride + kk * 8) = pack8(a);
    }
    if (ROPE && lane < nheads) rope24(src + lane * 96, dbase + (size_t)lane * hstride, cs, scale);
}

__device__ __forceinline__ void rope24_regs(const v4u c0, const v4u c1, const v4u c2, bf16* dst, const float (&cs)[24], float scale) {
    float v[24];
    { float a[8]; unpack8(c0, a);
#pragma unroll
      for (int i = 0; i < 8; ++i) v[i] = a[i];
      unpack8(c1, a);
#pragma unroll
      for (int i = 0; i < 8; ++i) v[8 + i] = a[i];
      unpack8(c2, a);
#pragma unroll
      for (int i = 0; i < 8; ++i) v[16 + i] = a[i]; }
    float o[24];
#pragma unroll
    for (int i = 0; i < 12; ++i) { const float c = cs[i], s = cs[12 + i]; o[i] = (v[i] * c - v[12 + i] * s) * scale; o[12 + i] = (v[12 + i] * c + v[i] * s) * scale; }
    float a[8];
#pragma unroll
    for (int i = 0; i < 8; ++i) a[i] = o[i];
    *(GAS v4u*)(dst) = pack8(a);
#pragma unroll
    for (int i = 0; i < 8; ++i) a[i] = o[8 + i];
    *(GAS v4u*)(dst + 8) = pack8(a);
#pragma unroll
    for (int i = 0; i < 8; ++i) a[i] = o[16 + i];
    *(GAS v4u*)(dst + 16) = pack8(a);
}
__device__ __forceinline__ v4u scale8(const v4u w, float scale) { float a[8]; unpack8(w, a);
#pragma unroll
    for (int i = 0; i < 8; ++i) a[i] *= scale;
    return pack8(a); }

__device__ __forceinline__ void p3_relayout(Frame& F, int vb, int nvb) {
    unsigned char* ws = F.ws;
    const bf16* PROJ = (const bf16*)(ws + WS_PROJ);
    const float* rope = (const float*)(ws + WS_SMALL + SM_ROPE);
    bf16* QR = (bf16*)(ws + WS_QR); bf16* KSG = (bf16*)(ws + WS_KSG); bf16* KWG = (bf16*)(ws + WS_KWG); bf16* KCG = (bf16*)(ws + WS_KCG); bf16* VCG = (bf16*)(ws + WS_VCG);
    bf16* VST = (bf16*)(ws + WS_VST); bf16* VWT = (bf16*)(ws + WS_VWT); bf16* DPOOL = (bf16*)(ws + WS_DPOOL);
    const int gw = vb * NWAVES + F.wave, NGW = nvb * NWAVES, lane = F.lane;
    LAS float* nrm = (LAS float*)(F.lds + RING_OFF + 73728 + F.wave * 512);
    float ksmax = 0.f, kwmax = 0.f;
    for (int t = gw; t < T; t += NGW) {
        const bf16* pr = PROJ + (size_t)t * NP;
        const float* csp = rope + t * 24;
        v4u qc[3];
#pragma unroll
        for (int i = 0; i < 3; ++i) qc[i] = *(const GAS v4u*)(pr + C_Q + (lane + 64 * i) * 8);
        const int l48 = lane < 48 ? lane : 47, l32 = lane & 31;
        const v4u ksc = *(const GAS v4u*)(pr + C_KS + l48 * 8), kwc = *(const GAS v4u*)(pr + C_KW + l48 * 8), kcc = *(const GAS v4u*)(pr + C_KC + l48 * 8), vcc = *(const GAS v4u*)(pr + C_VC + l32 * 8);
        v4u rq[3], rs[3], rw[3];
#pragma unroll
        for (int i = 0; i < 3; ++i) { rq[i] = *(const GAS v4u*)(pr + C_Q + (lane & 15) * DQK + 8 * i); rs[i] = *(const GAS v4u*)(pr + C_KS + (lane & 3) * DQK + 8 * i); rw[i] = *(const GAS v4u*)(pr + C_KW + (lane & 3) * DQK + 8 * i); }
        float cs[24];
#pragma unroll
        for (int i = 0; i < 24; ++i) cs[i] = csp[i];
        { float a[8], ss = 0.f, sw = 0.f; unpack8(ksc, a);
#pragma unroll
          for (int i = 0; i < 8; ++i) ss += a[i] * a[i];
          unpack8(kwc, a);
#pragma unroll
          for (int i = 0; i < 8; ++i) sw += a[i] * a[i];
          if (lane < 48) { nrm[lane] = ss; nrm[48 + lane] = sw; }
          LDS_WAIT(); asm volatile("" ::: "memory");
          if (lane < NG) { float s = 0.f, w2 = 0.f;
#pragma unroll
              for (int i = 0; i < 12; ++i) { s += nrm[12 * lane + i]; w2 += nrm[48 + 12 * lane + i]; }
              ksmax = fmaxf(ksmax, s); kwmax = fmaxf(kwmax, w2); }
          LDS_WAIT(); asm volatile("" ::: "memory"); }
        {
            const int ci = lane, g = ci >> 5, win = 2 << g, cnt = (t + 1 < win) ? (t + 1) : win;
            v4u w[4];
#pragma unroll
            for (int r = 0; r < 4; ++r) w[r] = (r < cnt) ? *(const GAS v4u*)(pr - (size_t)r * NP + C_U + ci * 8) : (v4u){0u, 0u, 0u, 0u};
            float s[8], u[8]; unpack8(w[0], u);
#pragma unroll
            for (int i = 0; i < 8; ++i) s[i] = u[i];
#pragma unroll
            for (int r = 1; r < 4; ++r) { float a[8]; unpack8(w[r], a);
#pragma unroll
                for (int i = 0; i < 8; ++i) s[i] += a[i]; }
            const float ic = 1.0f / (float)cnt;
#pragma unroll
            for (int i = 0; i < 8; ++i) s[i] = s[i] * ic - u[i];
            *(GAS v4u*)(DPOOL + (size_t)t * 1024 + ci * 8) = pack8(s);
        }
        {
            const int ci = 64 + lane, g = ci >> 5, win = 2 << g, cnt = (t + 1 < win) ? (t + 1) : win;
            v4u w[16];
#pragma unroll
            for (int r = 0; r < 16; ++r) w[r] = (r < cnt) ? *(const GAS v4u*)(pr - (size_t)r * NP + C_U + ci * 8) : (v4u){0u, 0u, 0u, 0u};
            float s[8], u[8]; unpack8(w[0], u);
#pragma unroll
            for (int i = 0; i < 8; ++i) s[i] = u[i];
#pragma unroll
            for (int r = 1; r < 16; ++r) { float a[8]; unpack8(w[r], a);
#pragma unroll
                for (int i = 0; i < 8; ++i) s[i] += a[i]; }
            const float ic = 1.0f / (float)cnt;
#pragma unroll
            for (int i = 0; i < 8; ++i) s[i] = s[i] * ic - u[i];
            *(GAS v4u*)(DPOOL + (size_t)t * 1024 + ci * 8) = pack8(s);
        }
        constexpr float QS = 0.14724444236568886f;
#pragma unroll
        for (int i = 0; i < 3; ++i) { const int ci = lane + 64 * i, head = ci / 12, kk = ci % 12;
            if (kk >= 3) *(GAS v4u*)(QR + (size_t)t * (NH * DQK) + head * DQK + kk * 8) = scale8(qc[i], QS); }
        if (lane < NH) rope24_regs(rq[0], rq[1], rq[2], QR + (size_t)t * (NH * DQK) + lane * DQK, cs, QS);
        if (lane < 48) { const int g = lane / 12, kk = lane % 12;
            if (kk >= 3) { *(GAS v4u*)(KSG + ((size_t)g * T + t) * DQK + kk * 8) = ksc; *(GAS v4u*)(KWG + ((size_t)g * T + t) * DQK + kk * 8) = kwc; }
            *(GAS v4u*)(KCG + ((size_t)g * T + t) * DQK + kk * 8) = kcc; }
        if (lane < NG) { rope24_regs(rs[0], rs[1], rs[2], KSG + ((size_t)lane * T + t) * DQK, cs, 1.0f); rope24_regs(rw[0], rw[1], rw[2], KWG + ((size_t)lane * T + t) * DQK, cs, 1.0f); }
        if (lane < 32) { const int g = lane >> 3, kk = lane & 7; *(GAS v4u*)(VCG + ((size_t)g * T + t) * DV + kk * 8) = vcc; }
    }
    { LAS float* bm = (LAS float*)(F.lds + RING_OFF + 73728 + 4096);
      if (lane < NG) { bm[F.wave * 8 + lane] = ksmax; bm[F.wave * 8 + 4 + lane] = kwmax; }
      __syncthreads();
      if (F.tid < 8) { float v = 0.f;
#pragma unroll
          for (int w = 0; w < NWAVES; ++w) v = fmaxf(v, bm[w * 8 + F.tid]);
          float* dst = (float*)(ws + WS_SMALL + (F.tid < 4 ? SM_KNS : SM_KNW)); dst[(F.tid & 3) * 256 + vb] = v; }
      __syncthreads(); }
    LAS bf16* tl = (LAS bf16*)(F.lds + RING_OFF + F.wave * 9216);
    for (int it = gw; it < 2 * NG * (T / 64); it += NGW) {
        const int tens = it / (NG * (T / 64)), rem = it % (NG * (T / 64)), g = rem / (T / 64), tt = rem % (T / 64);
        const bf16* src = PROJ + (size_t)(tt * 64 + lane) * NP + (tens ? C_VW : C_VS) + g * DV;
        bf16* dst = (tens ? VWT : VST) + ((size_t)g * DV) * T + tt * 64;
#pragma unroll
        for (int c = 0; c < 8; ++c) { const v4u w = *(const GAS v4u*)(src + c * 8);
            const unsigned ww[4] = {w.x, w.y, w.z, w.w};
#pragma unroll
            for (int q = 0; q < 4; ++q) { tl[(c * 8 + 2 * q) * 72 + lane] = (bf16)(ww[q] & 0xffffu); tl[(c * 8 + 2 * q + 1) * 72 + lane] = (bf16)(ww[q] >> 16); } }
        LDS_WAIT(); asm volatile("" ::: "memory");
#pragma unroll
        for (int c = 0; c < 8; ++c) { const v4u w = *(const LAS v4u*)(tl + lane * 72 + c * 8); *(GAS v4u*)(dst + (size_t)lane * T + c * 8) = w; }
        LDS_WAIT(); asm volatile("" ::: "memory");
    }
}
struct SchedPlain {
    int nM, nN, G, c; const char* Bt; unsigned lda2; size_t ldb2;
    __device__ __forceinline__ bool next(int i, pg8::Unit& u) const { u.aux = 0; return pg8::static_tile(i, G, c, nM, nN, u.pm, u.pn); }
    __device__ __forceinline__ unsigned aoff(const pg8::Unit& u, int r) const { return (unsigned)(u.pm * 256 + r) * lda2; }
    __device__ __forceinline__ const char* bptr(const pg8::Unit& u) const { return Bt + (size_t)u.pn * 256 * ldb2; }
};
struct SchedInTail {
    int c; const char* Bt; unsigned lda2; size_t ldb2;
    __device__ __forceinline__ bool next(int i, pg8::Unit& u) const { if (i != 0 || c < 0 || c >= 64) return false; u.pm = c >> 1; u.pn = 32 + (c & 1); u.aux = 0; return true; }
    __device__ __forceinline__ unsigned aoff(const pg8::Unit& u, int r) const { return (unsigned)(u.pm * 256 + r) * lda2; }
    __device__ __forceinline__ const char* bptr(const pg8::Unit& u) const { return Bt + (size_t)u.pn * 256 * ldb2; }
};
struct SchedPool {
    int G, c; const char* Bt;
    __device__ __forceinline__ bool next(int i, pg8::Unit& u) const { const int L = i * G + c; if (L >= 128) return false; u.pm = L >> 2; u.pn = 0; u.aux = L & 3; return true; }
    __device__ __forceinline__ unsigned aoff(const pg8::Unit& u, int r) const { return (unsigned)(u.pm * 256 + r) * 2048u + (unsigned)u.aux * 512u; }
    __device__ __forceinline__ const char* bptr(const pg8::Unit& u) const { return Bt + (size_t)u.aux * 65536 * 2; }
};
struct SchedSplitK {
    int nN, G, c; const char* Bt; unsigned lda2; size_t ldb2; int kslice;
    __device__ __forceinline__ bool next(int i, pg8::Unit& u) const { const int L = i * G + c; if (L < 0 || L >= 8 * nN * 4) return false; u.aux = L & 3; const int q = L >> 2; u.pn = q % nN; u.pm = q / nN; return true; }
    __device__ __forceinline__ unsigned aoff(const pg8::Unit& u, int r) const { return (unsigned)(u.pm * 256 + r) * lda2 + (unsigned)(u.aux * kslice) * 2u; }
    __device__ __forceinline__ const char* bptr(const pg8::Unit& u) const { return Bt + (size_t)u.pn * 256 * ldb2 + (size_t)u.aux * kslice * 2; }
};
struct SchedMoe1 {
    int G, c, ntiles; const LAS int* tile_e; const int* tok; const char* W1;
    __device__ __forceinline__ bool next(int i, pg8::Unit& u) const { const int L = i * G + c; if (L >= ntiles * 4) return false; u.pm = L >> 2; u.pn = L & 3; u.aux = tile_e[u.pm]; return true; }
    __device__ __forceinline__ unsigned aoff(const pg8::Unit& u, int r) const { return (unsigned)tok[u.pm * 256 + r] * 4096u; }
    __device__ __forceinline__ const char* bptr(const pg8::Unit& u) const { return W1 + ((size_t)u.aux * 1024 + (size_t)u.pn * 256) * 4096; }
};
struct SchedMoe2 {
    int G, c, ntiles; const LAS int* tile_e; const char* W2;
    __device__ __forceinline__ bool next(int i, pg8::Unit& u) const { const int L = i * G + c; if (L >= ntiles * 8) return false; u.pm = L >> 3; u.pn = L & 7; u.aux = tile_e[u.pm]; return true; }
    __device__ __forceinline__ unsigned aoff(const pg8::Unit& u, int r) const { return (unsigned)(u.pm * 256 + r) * 1024u; }
    __device__ __forceinline__ const char* bptr(const pg8::Unit& u) const { return W2 + ((size_t)u.aux * 2048 + (size_t)u.pn * 256) * 1024; }
};

using pg8::f32x4; using pg8::u32x4;
#define EPI_ARGS const f32x4 (&acc)[2][2][4][2], const pg8::Unit& u, int wr, int wc, int fr, int fq
struct EpiBf16 {
    static constexpr bool PERM = true;
    bf16* O; int ldc; int cbase; int caux;
    __device__ __forceinline__ void operator()(EPI_ARGS) const {
        const int row0 = u.pm * 256 + wr * 64 + fr, col0 = cbase + caux * u.aux + u.pn * 256 + wc * 32 + 8 * fq;
#pragma unroll
        for (int ai = 0; ai < 2; ++ai)
#pragma unroll
            for (int m = 0; m < 4; ++m) { bf16* rowp = O + (size_t)(row0 + ai * 128 + m * 16) * ldc + col0;
#pragma unroll
                for (int bj = 0; bj < 2; ++bj) { const f32x4 v0 = acc[ai][bj][m][0], v1 = acc[ai][bj][m][1];
                    u32x4 w; w.x = pg8::cvt_pk_bf16(v0[0], v0[1]); w.y = pg8::cvt_pk_bf16(v0[2], v0[3]); w.z = pg8::cvt_pk_bf16(v1[0], v1[1]); w.w = pg8::cvt_pk_bf16(v1[2], v1[3]);
                    *(u32x4*)(rowp + bj * 128) = w; } }
    }
};
struct EpiF32 {
    static constexpr bool PERM = false;
    float* C; int ldc; size_t astride;
    __device__ __forceinline__ void operator()(EPI_ARGS) const {
        const int row0 = u.pm * 256 + wr * 64 + fr, col0 = u.pn * 256 + wc * 32 + 4 * fq;
        float* base = C + (size_t)u.aux * astride;
#pragma unroll
        for (int ai = 0; ai < 2; ++ai)
#pragma unroll
            for (int m = 0; m < 4; ++m) { float* rowp = base + (size_t)(row0 + ai * 128 + m * 16) * ldc + col0;
#pragma unroll
                for (int bj = 0; bj < 2; ++bj)
#pragma unroll
                    for (int n = 0; n < 2; ++n) *(f32x4*)(rowp + bj * 128 + n * 16) = acc[ai][bj][m][n]; }
    }
};
__device__ __forceinline__ void sig8(const u32x4 w, float (&s)[8]) {
    s[0] = sigmoidf_(bflo(w.x)); s[1] = sigmoidf_(bfhi(w.x)); s[2] = sigmoidf_(bflo(w.y)); s[3] = sigmoidf_(bfhi(w.y));
    s[4] = sigmoidf_(bflo(w.z)); s[5] = sigmoidf_(bfhi(w.z)); s[6] = sigmoidf_(bflo(w.w)); s[7] = sigmoidf_(bfhi(w.w));
}
template <bool ADD>
struct EpiGate {
    static constexpr bool PERM = true;
    bf16* O; const bf16* prev; const bf16* GM; int gcol;
    __device__ __forceinline__ void operator()(EPI_ARGS) const {
        const int row0 = u.pm * 256 + wr * 64 + fr, col0 = u.pn * 256 + wc * 32 + 8 * fq;
#pragma unroll
        for (int ai = 0; ai < 2; ++ai)
#pragma unroll
            for (int m = 0; m < 4; ++m) { const size_t row = (size_t)(row0 + ai * 128 + m * 16);
#pragma unroll
                for (int bj = 0; bj < 2; ++bj) { const int col = col0 + bj * 128;
                    float s[8]; sig8(*(const u32x4*)(GM + row * NP + gcol + col), s);
                    const f32x4 v0 = acc[ai][bj][m][0], v1 = acc[ai][bj][m][1];
                    float r[8] = {v0[0] * s[0], v0[1] * s[1], v0[2] * s[2], v0[3] * s[3], v1[0] * s[4], v1[1] * s[5], v1[2] * s[6], v1[3] * s[7]};
                    if (ADD) { const u32x4 p = *(const u32x4*)(prev + row * 2048 + col);
                        r[0] += bflo(p.x); r[1] += bfhi(p.x); r[2] += bflo(p.y); r[3] += bfhi(p.y); r[4] += bflo(p.z); r[5] += bfhi(p.z); r[6] += bflo(p.w); r[7] += bfhi(p.w); }
                    u32x4 w; w.x = pg8::cvt_pk_bf16(r[0], r[1]); w.y = pg8::cvt_pk_bf16(r[2], r[3]); w.z = pg8::cvt_pk_bf16(r[4], r[5]); w.w = pg8::cvt_pk_bf16(r[6], r[7]);
                    *(u32x4*)(O + row * 2048 + col) = w; } }
    }
};
struct EpiMoe1 {
    static constexpr bool PERM = true;
    bf16* HID; const float* wrow;
    __device__ __forceinline__ void operator()(EPI_ARGS) const {
        const int row0 = u.pm * 256 + wr * 64 + fr, col0 = u.pn * 128 + wc * 32 + 8 * fq;
        float wv[2][4];
#pragma unroll
        for (int ai = 0; ai < 2; ++ai)
#pragma unroll
            for (int m = 0; m < 4; ++m) wv[ai][m] = wrow[row0 + ai * 128 + m * 16];
#pragma unroll
        for (int ai = 0; ai < 2; ++ai)
#pragma unroll
            for (int m = 0; m < 4; ++m) { const size_t row = (size_t)(row0 + ai * 128 + m * 16);
                float r[8];
#pragma unroll
                for (int n = 0; n < 2; ++n)
#pragma unroll
                    for (int j = 0; j < 4; ++j) { const float gt = acc[ai][0][m][n][j], up = acc[ai][1][m][n][j]; r[4 * n + j] = gt / (1.0f + __expf(-gt)) * up * wv[ai][m]; }
                u32x4 w; w.x = pg8::cvt_pk_bf16(r[0], r[1]); w.y = pg8::cvt_pk_bf16(r[2], r[3]); w.z = pg8::cvt_pk_bf16(r[4], r[5]); w.w = pg8::cvt_pk_bf16(r[6], r[7]);
                *(u32x4*)(HID + row * 512 + col0) = w; }
    }
};
struct EpiMoe2 {
    static constexpr bool PERM = true;
    bf16* YB; const float* wrow;
    __device__ __forceinline__ void operator()(EPI_ARGS) const {
        const int row0 = u.pm * 256 + wr * 64 + fr, col0 = u.pn * 256 + wc * 32 + 8 * fq;
#pragma unroll
        for (int ai = 0; ai < 2; ++ai)
#pragma unroll
            for (int m = 0; m < 4; ++m) { const size_t row = (size_t)(row0 + ai * 128 + m * 16); const float ws_ = wrow[row];
#pragma unroll
                for (int bj = 0; bj < 2; ++bj) { const f32x4 v0 = acc[ai][bj][m][0] * ws_, v1 = acc[ai][bj][m][1] * ws_;
                    u32x4 w; w.x = pg8::cvt_pk_bf16(v0[0], v0[1]); w.y = pg8::cvt_pk_bf16(v0[2], v0[3]); w.z = pg8::cvt_pk_bf16(v1[0], v1[1]); w.w = pg8::cvt_pk_bf16(v1[2], v1[3]);
                    *(u32x4*)(YB + row * 2048 + col0 + bj * 128) = w; } }
    }
};
__device__ __forceinline__ void p5_cmp2(Frame& F) {
    unsigned char* ws = F.ws;
    const float* PARTK = (const float*)(ws + WS_PARTK); const float* PARTV = (const float*)(ws + WS_PARTV);
    const float* biask = (const float*)(ws + WS_SMALL + SM_BIASK); const float* biasv = (const float*)(ws + WS_SMALL + SM_BIASV);
    const float* rope = (const float*)(ws + WS_SMALL + SM_ROPE);
    bf16* KCR = (bf16*)(ws + WS_KCR); bf16* VCT = (bf16*)(ws + WS_VCT);
    LAS bf16* w2k = (LAS bf16*)(F.lds + RING_OFF); LAS bf16* w2v = (LAS bf16*)(F.lds + RING_OFF + 73728);
    LAS float* hid = (LAS float*)(F.lds + RING_OFF + 106496 + F.wave * 3072);
    LAS float* ovp = hid + 384;
    const int gw = F.bid * NWAVES + F.wave, NGW = F.G * NWAVES, lane = F.lane, tid = F.tid;
    if (F.bid * NWAVES >= NG * NCMPP) return;
    { f32x4 wk[18], wv[8];
#pragma unroll
      for (int i = 0; i < 18; ++i) wk[i] = *(const GAS f32x4*)(F.cmp_k_w2 + 4 * (tid + 512 * i));
#pragma unroll
      for (int i = 0; i < 8; ++i) wv[i] = *(const GAS f32x4*)(F.cmp_v_w2 + 4 * (tid + 512 * i));
#pragma unroll
      for (int i = 0; i < 18; ++i) { v2u o; o.x = pk2(wk[i].x, wk[i].y); o.y = pk2(wk[i].z, wk[i].w); *(LAS v2u*)(w2k + 4 * (tid + 512 * i)) = o; }
#pragma unroll
      for (int i = 0; i < 8; ++i) { v2u o; o.x = pk2(wv[i].x, wv[i].y); o.y = pk2(wv[i].z, wv[i].w); *(LAS v2u*)(w2v + 4 * (tid + 512 * i)) = o; } }
    __syncthreads();
    for (int row = gw; row < NG * NCMPP; row += NGW) {
        const int g = row >> 9, n = row & 511;
        if (n == NCMP) {
            for (int j = lane; j < DQK; j += 64) KCR[(size_t)row * DQK + j] = 0;
            VCT[((size_t)g * DV + lane) * NCMPP + n] = 0;
            if (lane == 0) ((float*)(ws + WS_SMALL + SM_KNC))[row] = 0.f;
            continue;
        }
        float sk[6], sv[4];
#pragma unroll
        for (int i = 0; i < 6; ++i) { const int c = lane + 64 * i; sk[i] = biask[c];
#pragma unroll
            for (int ks = 0; ks < 4; ++ks) sk[i] += PARTK[((size_t)ks * 2048 + row) * 512 + c]; }
#pragma unroll
        for (int i = 0; i < 4; ++i) { const int c = lane + 64 * i; sv[i] = biasv[c];
#pragma unroll
            for (int ks = 0; ks < 4; ++ks) sv[i] += PARTV[((size_t)ks * 2048 + row) * 256 + c]; }
#pragma unroll
        for (int i = 0; i < 6; ++i) hid[lane + 64 * i] = sk[i] / (1.0f + __expf(-sk[i]));
        LDS_WAIT(); asm volatile("" ::: "memory");
        { const int kq = lane / 24, c4 = lane % 24; f32x4 a = (f32x4){0.f, 0.f, 0.f, 0.f};
          if (lane < 48) { const LAS bf16* wp = w2k + (192 * kq) * DQK + 4 * c4; const LAS float* hp = hid + 192 * kq;
#pragma unroll 16
              for (int c = 0; c < 192; ++c) { const v2u w = *(const LAS v2u*)(wp + c * DQK); const float hv = hp[c]; a.x += bflo(w.x) * hv; a.y += bfhi(w.x) * hv; a.z += bflo(w.y) * hv; a.w += bfhi(w.y) * hv; }
              ovp[kq * 96 + 4 * c4 + 0] = a.x; ovp[kq * 96 + 4 * c4 + 1] = a.y; ovp[kq * 96 + 4 * c4 + 2] = a.z; ovp[kq * 96 + 4 * c4 + 3] = a.w; } }
        LDS_WAIT(); asm volatile("" ::: "memory");
        { const float* cs = rope + (16 * n + 31) * 24;
          for (int j = lane; j < DQK; j += 64) { float v = ovp[j] + ovp[96 + j];
              if (j < HALFROT) v = v * cs[j] - (ovp[j + HALFROT] + ovp[96 + j + HALFROT]) * cs[HALFROT + j];
              else if (j < ROT) v = v * cs[j - HALFROT] + (ovp[j - HALFROT] + ovp[96 + j - HALFROT]) * cs[j];
              KCR[(size_t)row * DQK + j] = (bf16)f2bf(v); } }
        { float q2 = 0.f;
          for (int j = lane; j < DQK; j += 64) { const float v = ovp[j] + ovp[96 + j]; q2 += v * v; }
          q2 = wave_sum(q2);
          if (lane == 0) ((float*)(ws + WS_SMALL + SM_KNC))[row] = q2; }
        LDS_WAIT(); asm volatile("" ::: "memory");
#pragma unroll
        for (int i = 0; i < 4; ++i) hid[lane + 64 * i] = sv[i] / (1.0f + __expf(-sv[i]));
        LDS_WAIT(); asm volatile("" ::: "memory");
        { const int kq = lane >> 4, c4 = lane & 15; f32x4 a = (f32x4){0.f, 0.f, 0.f, 0.f};
          const LAS bf16* wp = w2v + (64 * kq) * DV + 4 * c4; const LAS float* hp = hid + 64 * kq;
#pragma unroll 16
          for (int c = 0; c < 64; ++c) { const v2u w = *(const LAS v2u*)(wp + c * DV); const float hv = hp[c]; a.x += bflo(w.x) * hv; a.y += bfhi(w.x) * hv; a.z += bflo(w.y) * hv; a.w += bfhi(w.y) * hv; }
          ovp[kq * 64 + 4 * c4 + 0] = a.x; ovp[kq * 64 + 4 * c4 + 1] = a.y; ovp[kq * 64 + 4 * c4 + 2] = a.z; ovp[kq * 64 + 4 * c4 + 3] = a.w; }
        LDS_WAIT(); asm volatile("" ::: "memory");
        VCT[((size_t)g * DV + lane) * NCMPP + n] = (bf16)f2bf((ovp[lane] + ovp[64 + lane]) + (ovp[128 + lane] + ovp[192 + lane]));
        LDS_WAIT(); asm volatile("" ::: "memory");
    }
}

namespace nsa {
typedef __bf16 bf16x2_t __attribute__((ext_vector_type(2)));
typedef float f32x2_t __attribute__((ext_vector_type(2)));
constexpr int NST = 4, ST_K = 12288, ST_V = 8192, ST_BYTES = ST_K + ST_V;
constexpr int L_KV = 0, L_IMP = NST * ST_BYTES, IMP_PITCH = 129, L_SEL = L_IMP + 64 * IMP_PITCH * 4, L_END = L_SEL + 64 * 8 * 2;
static_assert(L_END <= RING_BYTES, "attention LDS");
constexpr float NEGBIG = -1e30f;
__device__ __forceinline__ unsigned cvtpk(float lo, float hi) { f32x2_t v = {lo, hi}; bf16x2_t b = __builtin_convertvector(v, bf16x2_t); return __builtin_bit_cast(unsigned, b); }
__device__ __forceinline__ int crow(int i, int h) { return (i & 3) + 8 * (i >> 2) + 4 * h; }
#define MFMA32(a, b, c) __builtin_amdgcn_mfma_f32_32x32x16_bf16((a), (b), (c), 0, 0, 0)
#define NSA_WAIT_V(n) asm volatile("s_waitcnt vmcnt(" #n ")" ::: "memory")

struct DmaOff { unsigned o0, o1, o2; };
__device__ __forceinline__ unsigned dma_src(int ii, int lane, int vlen) {
    if (ii < 12) { const int q = 64 * ii + lane, p = q >> 8, qq = q & 255, row = qq >> 2, c = (qq & 3) ^ ((row >> 2) & 3); return (unsigned)(row * DQK + (4 * p + c) * 8); }
    const int q = 64 * (ii - 12) + lane, dv = q >> 3, cv = (q & 7) ^ ((dv >> 1) & 7); return (unsigned)(dv * vlen + cv * 8);
}
template <bool WITH_V>
__device__ __forceinline__ void tile_dma(LAS unsigned char* stage, const bf16* ksrc, const bf16* vsrc, const DmaOff& D, int w) {
    __builtin_amdgcn_global_load_lds((const unsigned*)(ksrc + D.o0), (LAS unsigned*)(stage + w * 1024), 16, 0, 0);
    if (w < 4) __builtin_amdgcn_global_load_lds((const unsigned*)(ksrc + D.o1), (LAS unsigned*)(stage + (w + 8) * 1024), 16, 0, 0);
    if (WITH_V) {
        if (w >= 4) __builtin_amdgcn_global_load_lds((const unsigned*)(vsrc + D.o1), (LAS unsigned*)(stage + (w + 8) * 1024), 16, 0, 0);
        else __builtin_amdgcn_global_load_lds((const unsigned*)(vsrc + D.o2), (LAS unsigned*)(stage + (w + 16) * 1024), 16, 0, 0);
    }
}

typedef float f32x2v __attribute__((ext_vector_type(2)));
__device__ __forceinline__ float quad_sum(float v) {
    v += __builtin_bit_cast(float, __builtin_amdgcn_update_dpp(0, __builtin_bit_cast(int, v), 0xB1, 0xf, 0xf, false));
    v += __builtin_bit_cast(float, __builtin_amdgcn_update_dpp(0, __builtin_bit_cast(int, v), 0x4E, 0xf, 0xf, false));
    return v; }
__device__ __forceinline__ float xhalf_max(float v) { const auto r = __builtin_amdgcn_permlane32_swap(__builtin_bit_cast(unsigned, v), __builtin_bit_cast(unsigned, v), false, false);
    return __builtin_fmaxf(__builtin_bit_cast(float, r[0]), __builtin_bit_cast(float, r[1])); }
__device__ __forceinline__ float xhalf_sum(float v) { const auto r = __builtin_amdgcn_permlane32_swap(__builtin_bit_cast(unsigned, v), __builtin_bit_cast(unsigned, v), false, false);
    return __builtin_bit_cast(float, r[0]) + __builtin_bit_cast(float, r[1]); }

template <int MODE, bool MASKED>
__device__ __forceinline__ void subtile(const LAS unsigned char* st, LAS float* IMP, int sub, int key0,
                                        const bf16x8 (&qf)[6], int t, int tok_l, int head, int r, int h, unsigned selbit,
                                        float& m, float& l, float linv, f32x16 (&O)[2]) {
    f32x16 x;
#pragma unroll
    for (int i = 0; i < 16; ++i) x[i] = 0.f;
    const unsigned kb0 = (unsigned)(size_t)st + 64u * (unsigned)r + ((unsigned)((h ^ (r >> 2)) & 3) << 4) + (unsigned)(sub * 2048);
#pragma unroll
    for (int s = 0; s < 6; ++s) { const bf16x8 kf = *(const LAS bf16x8*)(size_t)((kb0 ^ ((unsigned)(s & 1) << 5)) + (unsigned)((s >> 1) * 4096)); x = MFMA32(kf, qf[s], x); }
    if (MASKED) {
#pragma unroll
        for (int i = 0; i < 16; ++i) { const int kp = key0 + 32 * sub + crow(i, h); bool ok;
            if (MODE <= 1) ok = (16 * kp + 31 <= t);
            else if (MODE == 2) ok = (selbit != 0u) && (kp <= t);
            else ok = (kp <= t) && (kp > t - WIN);
            x[i] = ok ? x[i] : NEGBIG; }
    }
    if (MODE != 1) {
        float mloc = x[0];
#pragma unroll
        for (int i = 1; i < 16; ++i) mloc = __builtin_fmaxf(mloc, x[i]);
        if (MODE == 2 && !MASKED) mloc = selbit ? mloc : NEGBIG;
        mloc = __builtin_fmaxf(mloc, __shfl_xor(mloc, 32));
        const float mnew = __builtin_fmaxf(m, mloc);
        if (__builtin_amdgcn_ballot_w64(mnew != m) != 0ull) {
            const float alpha = __builtin_amdgcn_exp2f(m - mnew);
            l *= alpha;
            if (MODE >= 2) {
#pragma unroll
                for (int i = 0; i < 16; ++i) { O[0][i] *= alpha; O[1][i] *= alpha; }
            }
            m = mnew;
        }
        float mb = m;
        if (MODE == 2 && !MASKED) mb = selbit ? m : 1e30f;
        if (MASKED) mb = (m > 0.5f * NEGBIG) ? m : 1e30f;
        const f32x2v mm = {mb, mb}; f32x2v ps = {0.f, 0.f};
#pragma unroll
        for (int i = 0; i < 8; ++i) { f32x2v d = (f32x2v){x[2 * i], x[2 * i + 1]} - mm; d.x = __builtin_amdgcn_exp2f(d.x); d.y = __builtin_amdgcn_exp2f(d.y); ps += d; x[2 * i] = d.x; x[2 * i + 1] = d.y; }
        l += ps.x + ps.y;
    } else {
        const f32x2v mm = {m, m};
#pragma unroll
        for (int i = 0; i < 8; ++i) { f32x2v d = (f32x2v){x[2 * i], x[2 * i + 1]} - mm; x[2 * i] = __builtin_amdgcn_exp2f(d.x) * linv; x[2 * i + 1] = __builtin_amdgcn_exp2f(d.y) * linv; }
#pragma unroll
        for (int a = 0; a < 4; ++a) {
            float vm = (x[4 * a] + x[4 * a + 1]) + (x[4 * a + 2] + 0.5f * x[4 * a + 3]), vs = 0.5f * x[4 * a + 3];
            vm = quad_sum(vm); vs = quad_sum(vs);
            const int j = (key0 + 32 * sub) / 4 + 2 * a + h;
            if (head == 0) { const unsigned ad = (unsigned)(size_t)(IMP + tok_l * IMP_PITCH + j);
                asm volatile("ds_add_f32 %0, %1" :: "v"(ad), "v"(vm) : "memory");
                if (j + 1 < NSLC) asm volatile("ds_add_f32 %0, %1 offset:4" :: "v"(ad), "v"(vs) : "memory"); }
        }
    }
    if (MODE != 0) {
#pragma unroll
        for (int s = 0; s < 2; ++s) {
            v4u pw; pw.x = cvtpk(x[8 * s], x[8 * s + 1]); pw.y = cvtpk(x[8 * s + 2], x[8 * s + 3]); pw.z = cvtpk(x[8 * s + 4], x[8 * s + 5]); pw.w = cvtpk(x[8 * s + 6], x[8 * s + 7]);
            const bf16x8 pf = __builtin_bit_cast(bf16x8, pw);
#pragma unroll
            for (int dvt = 0; dvt < 2; ++dvt) {
                const unsigned cv = (unsigned)(4 * sub + 2 * s), vb = (unsigned)(size_t)st + (unsigned)ST_K + 128u * (unsigned)r + 8u * (unsigned)h + ((unsigned)((r >> 1) & 7) << 4) + (unsigned)(dvt * 4096);
                const v2u lo = *(const LAS v2u*)(size_t)(vb ^ (cv << 4)), hi = *(const LAS v2u*)(size_t)(vb ^ ((cv + 1u) << 4));
                v4u vw; vw.x = lo.x; vw.y = lo.y; vw.z = hi.x; vw.w = hi.y;
                O[dvt] = MFMA32(__builtin_bit_cast(bf16x8, vw), pf, O[dvt]);
            }
        }
    }
}

__device__ __forceinline__ void tile_qk(const LAS unsigned char* st, const bf16x8 (&qf)[6], int r, int h, f32x16& xa, f32x16& xb) {
#pragma unroll
    for (int i = 0; i < 16; ++i) { xa[i] = 0.f; xb[i] = 0.f; }
    const unsigned kb0 = (unsigned)(size_t)st + 64u * (unsigned)r + ((unsigned)((h ^ (r >> 2)) & 3) << 4);
    bf16x8 ka[6], kb[6];
#pragma unroll
    for (int s = 0; s < 6; ++s) {
        const unsigned ka_ = (kb0 ^ ((unsigned)(s & 1) << 5)) + (unsigned)((s >> 1) * 4096);
        ka[s] = *(const LAS bf16x8*)(size_t)ka_; kb[s] = *(const LAS bf16x8*)(size_t)(ka_ + 2048u);
    }
    __builtin_amdgcn_sched_barrier(0);
#pragma unroll
    for (int s = 0; s < 6; ++s) { xa = MFMA32(ka[s], qf[s], xa); xb = MFMA32(kb[s], qf[s], xb); }
}

template <int MODE>
__device__ __forceinline__ void tile_sm(const LAS unsigned char* st, int r, int h, unsigned selbit, float M, float& l, f32x16 (&O)[2], f32x16& xa, f32x16& xb, bool masked, int key0, int t) {
    if (masked) {
#pragma unroll
        for (int i = 0; i < 16; ++i) {
            const int ka = key0 + crow(i, h), kb = ka + 32; bool oa, ob;
            if (MODE == 0) { oa = (16 * ka + 31 <= t); ob = (16 * kb + 31 <= t); }
            else if (MODE == 2) { oa = (ka <= t); ob = (kb <= t); }
            else { oa = (ka <= t) && (ka > t - WIN); ob = (kb <= t) && (kb > t - WIN); }
            xa[i] = oa ? xa[i] : NEGBIG; xb[i] = ob ? xb[i] : NEGBIG; }
    }
    v4u vf[4][2];
    if (MODE != 0) {
        const unsigned vb = (unsigned)(size_t)st + (unsigned)ST_K + 128u * (unsigned)r + 8u * (unsigned)h + ((unsigned)((r >> 1) & 7) << 4);
#pragma unroll
        for (int q = 0; q < 4; ++q)
#pragma unroll
            for (int dvt = 0; dvt < 2; ++dvt) {
                const v2u lo = *(const LAS v2u*)(size_t)((vb ^ ((unsigned)(2 * q) << 4)) + (unsigned)(dvt * 4096)), hi = *(const LAS v2u*)(size_t)((vb ^ ((unsigned)(2 * q + 1) << 4)) + (unsigned)(dvt * 4096));
                vf[q][dvt].x = lo.x; vf[q][dvt].y = lo.y; vf[q][dvt].z = hi.x; vf[q][dvt].w = hi.y; }
    }
    const float mb = (MODE == 2 && selbit == 0u) ? 1e30f : M;
    const f32x2v mm = {mb, mb}; f32x2v ps = {0.f, 0.f};
#pragma unroll
    for (int i = 0; i < 8; ++i) {
        f32x2v d = (f32x2v){xa[2 * i], xa[2 * i + 1]} - mm; d.x = __builtin_amdgcn_exp2f(d.x); d.y = __builtin_amdgcn_exp2f(d.y); ps += d; xa[2 * i] = d.x; xa[2 * i + 1] = d.y;
        f32x2v e = (f32x2v){xb[2 * i], xb[2 * i + 1]} - mm; e.x = __builtin_amdgcn_exp2f(e.x); e.y = __builtin_amdgcn_exp2f(e.y); ps += e; xb[2 * i] = e.x; xb[2 * i + 1] = e.y;
    }
    l += ps.x + ps.y;
    if (MODE != 0) {
#pragma unroll
        for (int sub = 0; sub < 2; ++sub)
#pragma unroll
            for (int s = 0; s < 2; ++s) {
                v4u pw;
                if (sub == 0) { pw.x = cvtpk(xa[8 * s], xa[8 * s + 1]); pw.y = cvtpk(xa[8 * s + 2], xa[8 * s + 3]); pw.z = cvtpk(xa[8 * s + 4], xa[8 * s + 5]); pw.w = cvtpk(xa[8 * s + 6], xa[8 * s + 7]); }
                else { pw.x = cvtpk(xb[8 * s], xb[8 * s + 1]); pw.y = cvtpk(xb[8 * s + 2], xb[8 * s + 3]); pw.z = cvtpk(xb[8 * s + 4], xb[8 * s + 5]); pw.w = cvtpk(xb[8 * s + 6], xb[8 * s + 7]); }
                const bf16x8 pf = __builtin_bit_cast(bf16x8, pw);
#pragma unroll
                for (int dvt = 0; dvt < 2; ++dvt) O[dvt] = MFMA32(__builtin_bit_cast(bf16x8, vf[2 * sub + s][dvt]), pf, O[dvt]);
            }
    }
}

template <int MODE>
__device__ __forceinline__ void branch(LAS unsigned char* lds, const bf16* kbase, const bf16* vbase, int vlen, int tile0, int ntiles, int qt,
                                       const bf16x8 (&qf)[6], int t, int tok_l, int head, int r, int h, int tid,
                                       float& m, float& l, float linv, f32x16 (&O)[2]) {
    constexpr bool WITH_V = (MODE != 0);
    LAS float* IMP = (LAS float*)(lds + L_IMP);
    const LAS unsigned short* SEL = (const LAS unsigned short*)(lds + L_SEL);
    const int t0 = qt * 64, w = __builtin_amdgcn_readfirstlane(tid >> 6), lane = tid & 63;
    unsigned long long sel_lo = ~0ull, sel_hi = ~0ull;
    if (MODE == 2) { sel_lo = *(const LAS unsigned long long*)(SEL + tok_l * 8); sel_hi = *(const LAS unsigned long long*)(SEL + tok_l * 8 + 4); }
    DmaOff D; D.o0 = dma_src(w, lane, vlen); D.o1 = dma_src(w + 8, lane, vlen); D.o2 = dma_src(w + 16 < 20 ? w + 16 : 19, lane, vlen);
    NSA_WAIT_V(0);
    __builtin_amdgcn_s_barrier();
#pragma unroll
    for (int s = 0; s < NST - 1; ++s)
        if (s < ntiles) tile_dma<WITH_V>(lds + L_KV + s * ST_BYTES, kbase + (size_t)(tile0 + s) * 64 * DQK, vbase + (tile0 + s) * 64, D, w);
    for (int it = 0; it < ntiles; ++it) {
        const int j = tile0 + it, key0 = j * 64;
        if (it + NST - 2 < ntiles) { if (WITH_V) NSA_WAIT_V(4); else NSA_WAIT_V(2); } else NSA_WAIT_V(0);
        __builtin_amdgcn_s_barrier();
        if (it + NST - 1 < ntiles) tile_dma<WITH_V>(lds + L_KV + ((it + NST - 1) % NST) * ST_BYTES, kbase + (size_t)(j + NST - 1) * 64 * DQK, vbase + (j + NST - 1) * 64, D, w);
        const LAS unsigned char* st = lds + L_KV + (it % NST) * ST_BYTES;
        unsigned selbit = 1u; bool masked, active = true;
        if (MODE <= 1) masked = (16 * (key0 + 63) + 31 > t0);
        else if (MODE == 2) { selbit = (unsigned)(((j < 64) ? (sel_lo >> j) : (sel_hi >> (j - 64))) & 1ull); masked = (j == qt); active = __builtin_amdgcn_ballot_w64(selbit != 0u) != 0ull; }
        else masked = (j == qt) || (j + 8 == qt);
        if (active) {
            if (MODE != 1) { f32x16 xa, xb; tile_qk(st, qf, r, h, xa, xb); tile_sm<MODE == 1 ? 0 : MODE>(st, r, h, selbit, m, l, O, xa, xb, masked, key0, t); }
            else {
#pragma nounroll
                for (int sub = 0; sub < 2; ++sub) { if (masked) subtile<MODE, true>(st, IMP, sub, key0, qf, t, tok_l, head, r, h, selbit, m, l, linv, O);
                    else subtile<MODE, false>(st, IMP, sub, key0, qf, t, tok_l, head, r, h, selbit, m, l, linv, O); }
            }
        }
    }
    asm volatile("s_waitcnt lgkmcnt(0)" ::: "memory");
    __builtin_amdgcn_s_barrier();
}

__device__ __forceinline__ void topk_token(LAS float* IMP, LAS unsigned short* SEL, int tk, int cur, int lane) {
    const int j0 = lane, j1 = lane + 64;
    const bool v0 = j0 <= cur, v1 = j1 <= cur;
    const bool f0 = (j0 == 0) || (j0 == cur) || (j0 == cur - 1), f1 = (j1 == cur) || (j1 == cur - 1);
    const unsigned FORCED = 0x7149F2CBu;
    const unsigned k0 = v0 ? (f0 ? FORCED : __builtin_bit_cast(unsigned, IMP[tk * IMP_PITCH + j0]) + 1u) : 0u;
    const unsigned k1 = v1 ? (f1 ? FORCED : __builtin_bit_cast(unsigned, IMP[tk * IMP_PITCH + j1]) + 1u) : 0u;
    unsigned V = 0u;
#pragma nounroll
    for (int bit = 30; bit >= 0; --bit) {
        const unsigned cand = V | (1u << bit);
        const int c = __builtin_popcountll(__builtin_amdgcn_ballot_w64(k0 >= cand)) + __builtin_popcountll(__builtin_amdgcn_ballot_w64(k1 >= cand));
        V = (c >= NSEL) ? cand : V;
    }
    const unsigned long long gt0 = __builtin_amdgcn_ballot_w64(k0 > V), gt1 = __builtin_amdgcn_ballot_w64(k1 > V);
    const unsigned long long eq0 = __builtin_amdgcn_ballot_w64(k0 == V), eq1 = __builtin_amdgcn_ballot_w64(k1 == V);
    const int need = NSEL - (__builtin_popcountll(gt0) + __builtin_popcountll(gt1));
    const unsigned long long below = (lane == 0) ? 0ull : (~0ull >> (64 - lane));
    const int p0 = __builtin_popcountll(eq0 & below), p1 = __builtin_popcountll(eq0) + __builtin_popcountll(eq1 & below);
    const bool s0 = v0 && ((k0 > V) || ((k0 == V) && p0 < need)), s1 = v1 && ((k1 > V) || ((k1 == V) && p1 < need));
    const unsigned long long b0 = __builtin_amdgcn_ballot_w64(s0), b1 = __builtin_amdgcn_ballot_w64(s1);
    if (lane == 0) { *(LAS unsigned long long*)(SEL + tk * 8) = b0; *(LAS unsigned long long*)(SEL + tk * 8 + 4) = b1; }
}

__device__ __forceinline__ void attn_unit(Frame& F, int qt, int g) {
    unsigned char* ws = F.ws;
    LAS unsigned char* lds = F.lds + RING_OFF;
    const bf16* PROJ = (const bf16*)(ws + WS_PROJ); const bf16* QR = (const bf16*)(ws + WS_QR);
    const bf16* KSG = (const bf16*)(ws + WS_KSG) + (size_t)g * T * DQK; const bf16* KWG = (const bf16*)(ws + WS_KWG) + (size_t)g * T * DQK;
    const bf16* VST = (const bf16*)(ws + WS_VST) + (size_t)g * DV * T; const bf16* VWT = (const bf16*)(ws + WS_VWT) + (size_t)g * DV * T;
    const bf16* KCR = (const bf16*)(ws + WS_KCR) + (size_t)g * NCMPP * DQK; const bf16* VCT = (const bf16*)(ws + WS_VCT) + (size_t)g * DV * NCMPP;
    bf16* OB = (bf16*)(ws + WS_O);
    const int tid = F.tid, lane = F.lane, w = F.wave, r = lane & 31, h = lane >> 5, tok_l = 8 * w + (r >> 2), head = r & 3;
    const int t0 = qt * 64, t = t0 + tok_l, hg = 4 * g + head;
    LAS float* IMP = (LAS float*)(lds + L_IMP);
    LAS unsigned short* SEL = (LAS unsigned short*)(lds + L_SEL);
    for (int i = tid; i < 64 * IMP_PITCH; i += 512) IMP[i] = 0.f;
    bf16x8 qf[6];
#pragma unroll
    for (int s = 0; s < 6; ++s) { v4u qv = *(const GAS v4u*)(QR + (size_t)t * (NH * DQK) + hg * DQK + 16 * s + 8 * h);
        asm volatile("" : "+v"(qv));
        qf[s] = __builtin_bit_cast(bf16x8, qv); }
    unsigned gr0 = PROJ[(size_t)t * NP + C_GN + hg * 3 + 0], gr1 = PROJ[(size_t)t * NP + C_GN + hg * 3 + 1], gr2 = PROJ[(size_t)t * NP + C_GN + hg * 3 + 2];
    asm volatile("" : "+v"(gr0), "+v"(gr1), "+v"(gr2));
    const float g0 = sigmoidf_(bf2f(gr0)), g1 = sigmoidf_(bf2f(gr1)), g2 = sigmoidf_(bf2f(gr2));
    float Mc, Ms, Mw;
    { float q2 = 0.f;
#pragma unroll
      for (int s = 0; s < 6; ++s) { float a[8]; unpack8(__builtin_bit_cast(v4u, qf[s]), a);
#pragma unroll
          for (int i = 0; i < 8; ++i) q2 += a[i] * a[i]; }
      q2 += __shfl_xor(q2, 32);
      const float* sm = (const float*)(ws + WS_SMALL);
      const int nvb = (F.G == 256) ? 192 : F.G;
      float ks2 = 0.f, kw2 = 0.f, kc2 = 0.f;
#pragma unroll
      for (int i = 0; i < 4; ++i) { const int b = lane + 64 * i; if (b < nvb) { ks2 = fmaxf(ks2, sm[SM_KNS / 4 + g * 256 + b]); kw2 = fmaxf(kw2, sm[SM_KNW / 4 + g * 256 + b]); } }
#pragma unroll
      for (int i = 0; i < 8; ++i) kc2 = fmaxf(kc2, sm[SM_KNC / 4 + g * NCMPP + lane + 64 * i]);
#pragma unroll
      for (int o = 1; o < 64; o <<= 1) { ks2 = fmaxf(ks2, __shfl_xor(ks2, o)); kw2 = fmaxf(kw2, __shfl_xor(kw2, o)); kc2 = fmaxf(kc2, __shfl_xor(kc2, o)); }
      const float qn = sqrtf(q2) * 1.02f;
      Mc = qn * sqrtf(kc2) + 1e-3f; Ms = qn * sqrtf(ks2) + 1e-3f; Mw = qn * sqrtf(kw2) + 1e-3f;
      asm volatile("" : "+v"(Mc), "+v"(Ms), "+v"(Mw)); }
    f32x16 O[2];
#pragma unroll
    for (int i = 0; i < 16; ++i) { O[0][i] = 0.f; O[1][i] = 0.f; }
    float* OACC = (float*)(ws + WS_X1) + (size_t)t * 1024 + hg * DV + 4 * h;
    __syncthreads();
    {
        const int nmax = (t0 + 63 - 31) >> 4, ntiles = (nmax >> 6) + 1;
        float m = Mc, l = 0.f;
        branch<0>(lds, KCR, VCT, NCMPP, 0, ntiles, qt, qf, t, tok_l, head, r, h, tid, m, l, 0.f, O);
        const float lt = l + __shfl_xor(l, 32);
        const float linv = lt > 0.f ? 1.0f / lt : 0.f;
        branch<1>(lds, KCR, VCT, NCMPP, 0, ntiles, qt, qf, t, tok_l, head, r, h, tid, m, l, linv, O);
#pragma unroll
        for (int dvt = 0; dvt < 2; ++dvt)
#pragma unroll
            for (int a = 0; a < 4; ++a) { f32x4 v; v.x = g0 * O[dvt][4 * a]; v.y = g0 * O[dvt][4 * a + 1]; v.z = g0 * O[dvt][4 * a + 2]; v.w = g0 * O[dvt][4 * a + 3];
                *(GAS f32x4*)(OACC + 32 * dvt + 8 * a) = v; }
#pragma unroll
        for (int i = 0; i < 16; ++i) { O[0][i] = 0.f; O[1][i] = 0.f; }
    }
#if defined(ABL) && (ABL & 16)
    if (lane < 8) { *(LAS unsigned long long*)(SEL + (8 * w + lane) * 8) = ~0ull; *(LAS unsigned long long*)(SEL + (8 * w + lane) * 8 + 4) = ~0ull; }
#else
#pragma nounroll
    for (int q = 0; q < 8; ++q) topk_token(IMP, SEL, 8 * w + q, qt, lane);
#endif
    __syncthreads();
    {
        float m = Ms, l = 0.f;
        branch<2>(lds, KSG, VST, T, 0, qt + 1, qt, qf, t, tok_l, head, r, h, tid, m, l, 0.f, O);
        const float lt = l + __shfl_xor(l, 32);
        const float sc = lt > 0.f ? g1 / lt : 0.f;
#pragma unroll
        for (int dvt = 0; dvt < 2; ++dvt)
#pragma unroll
            for (int a = 0; a < 4; ++a) { f32x4 v = *(const GAS f32x4*)(OACC + 32 * dvt + 8 * a);
                v.x += sc * O[dvt][4 * a]; v.y += sc * O[dvt][4 * a + 1]; v.z += sc * O[dvt][4 * a + 2]; v.w += sc * O[dvt][4 * a + 3];
                *(GAS f32x4*)(OACC + 32 * dvt + 8 * a) = v; }
#pragma unroll
        for (int i = 0; i < 16; ++i) { O[0][i] = 0.f; O[1][i] = 0.f; }
    }
    {
        const int tile0 = qt >= 8 ? qt - 8 : 0;
        float m = Mw, l = 0.f;
        branch<3>(lds, KWG, VWT, T, tile0, qt - tile0 + 1, qt, qf, t, tok_l, head, r, h, tid, m, l, 0.f, O);
        const float lt = l + __shfl_xor(l, 32);
        const float sc = lt > 0.f ? g2 / lt : 0.f;
#pragma unroll
        for (int dvt = 0; dvt < 2; ++dvt)
#pragma unroll
            for (int a = 0; a < 4; ++a) { const f32x4 v = *(const GAS f32x4*)(OACC + 32 * dvt + 8 * a);
                v2u o; o.x = cvtpk(v.x + sc * O[dvt][4 * a], v.y + sc * O[dvt][4 * a + 1]); o.y = cvtpk(v.z + sc * O[dvt][4 * a + 2], v.w + sc * O[dvt][4 * a + 3]);
                *(GAS v2u*)(OB + (size_t)t * 1024 + hg * DV + 32 * dvt + 8 * a + 4 * h) = o; }
    }
}
__device__ __forceinline__ void p6_attention(Frame& F) {
    for (int u2 = 2 * F.bid; u2 < 512; u2 += ((u2 & 1) ? 2 * F.G - 1 : 1)) {
        const int u = u2 >> 1, g = u & 3, pr = u >> 2;
        attn_unit(F, (u2 & 1) ? 127 - pr : pr, g);
        __syncthreads();
    }
}
#undef MFMA32
}
constexpr int LX_TILE_E = LDS_X;
constexpr int LX_PSTART = LDS_X + 1408;
constexpr int LX_NTILES = LDS_X + 1408 + 272;
static_assert(LX_NTILES + 4 <= LDS_BYTES, "LDS_X");

__device__ __forceinline__ void p9_post_router(Frame& F) {
    unsigned char* ws = F.ws;
    const float* mod = (const float*)(ws + WS_SMALL + SM_MOD);
    const bf16* Z = (const bf16*)(ws + WS_Z);
    float* X1 = (float*)(ws + WS_X1);
    bf16* H2HI = (bf16*)(ws + WS_H2HI); bf16* H2LO = (bf16*)(ws + WS_H2LO);
    const bf16* WRH = (const bf16*)(ws + WS_WRT); const bf16* WRL = WRH + 64 * 2048;
    int* SELE = (int*)(ws + WS_TAB + TB_SELE); float* SELW = (float*)(ws + WS_TAB + TB_SELW); int* SELR = (int*)(ws + WS_TAB + TB_SELR);
    unsigned* CNT = (unsigned*)(F.ctl + CW_CNT);
    LAS float* RED = (LAS float*)(F.lds + RING_OFF);
    LAS float* LOG = (LAS float*)(F.lds + RING_OFF + 65536);
    LAS int* LCNT = (LAS int*)(F.lds + RING_OFF + 65536 + 8192);
    LAS int* LBASE = LCNT + 64;
    LAS int* LE = LBASE + 64;
    LAS int* LR = LE + 256;
    int tid = F.tid;
    LAS float* PA = (LAS float*)(F.lds + RING_OFF + 81920); LAS float* PB = PA + 2048; LAS float* PC = PB + 2048;
#pragma unroll
    for (int i = 0; i < 4; ++i) { const int c = tid + 512 * i; PA[c] = F.g_post_mix[c] * mod[2 * D + c]; PB[c] = F.g_pre_ffn[c] * (mod[4 * D + c] + 1.0f); PC[c] = mod[3 * D + c]; }
    __syncthreads();
    for (int rt = F.bid; rt < T / 32; rt += F.G) {
        asm volatile("" : "+v"(tid));
        const int lane = tid & 63, w = __builtin_amdgcn_readfirstlane(tid >> 6);
        const int row0 = rt * 32;
        if (tid < 64) LCNT[tid] = 0;
        {
            f32x4 zc[8], xc[8]; v2u zn[8];
            { const GAS v2u* zr = (const GAS v2u*)(Z + (size_t)(row0 + 4 * w) * D) + lane;
#pragma unroll
              for (int j = 0; j < 8; ++j) { const v2u z2 = zr[64 * j]; zc[j] = (f32x4){bflo(z2.x), bfhi(z2.x), bflo(z2.y), bfhi(z2.y)}; } }
#pragma nounroll
            for (int q = 0; q < 4; ++q) {
                const int row = row0 + 4 * w + q;
                { const GAS f32x4* xr = (const GAS f32x4*)(F.x + (size_t)row * D) + lane;
#pragma unroll
                  for (int j = 0; j < 8; ++j) xc[j] = xr[64 * j]; }
                if (q < 3) { const GAS v2u* zr = (const GAS v2u*)(Z + (size_t)(row + 1) * D) + lane;
#pragma unroll
                    for (int j = 0; j < 8; ++j) zn[j] = zr[64 * j]; }
                float ss = 0.f;
#pragma unroll
                for (int j = 0; j < 8; ++j) ss += (zc[j].x * zc[j].x + zc[j].y * zc[j].y) + (zc[j].z * zc[j].z + zc[j].w * zc[j].w);
                const float rstd = 1.0f / sqrtf(wave_sum(ss) * (1.0f / D) + RMS_EPS);
                float s2 = 0.f;
#pragma unroll
                for (int j = 0; j < 8; ++j) { const int col = 4 * (lane + 64 * j);
                    const f32x4 pa = *(const LAS f32x4*)(PA + col);
                    zc[j] = xc[j] + (zc[j] * rstd) * pa;
                    s2 += (zc[j].x * zc[j].x + zc[j].y * zc[j].y) + (zc[j].z * zc[j].z + zc[j].w * zc[j].w);
                    *((GAS f32x4*)(X1 + (size_t)row * D) + lane + 64 * j) = zc[j]; }
                const float rstd2 = 1.0f / sqrtf(wave_sum(s2) * (1.0f / D) + RMS_EPS);
#pragma unroll
                for (int j = 0; j < 8; ++j) { const int col = 4 * (lane + 64 * j);
                    const f32x4 pb = *(const LAS f32x4*)(PB + col), pc = *(const LAS f32x4*)(PC + col);
                    const f32x4 hv = (zc[j] * rstd2) * pb + pc;
                    const unsigned h0 = f2bf(hv.x), h1 = f2bf(hv.y), h2 = f2bf(hv.z), h3 = f2bf(hv.w);
                    v2u hi; hi.x = h0 | (h1 << 16); hi.y = h2 | (h3 << 16);
                    v2u lo; lo.x = pk2(hv.x - bf2f(h0), hv.y - bf2f(h1)); lo.y = pk2(hv.z - bf2f(h2), hv.w - bf2f(h3));
                    *((GAS v2u*)(H2HI + (size_t)row * D) + lane + 64 * j) = hi; *((GAS v2u*)(H2LO + (size_t)row * D) + lane + 64 * j) = lo; }
                if (q < 3) {
#pragma unroll
                    for (int j = 0; j < 8; ++j) zc[j] = (f32x4){bflo(zn[j].x), bfhi(zn[j].x), bflo(zn[j].y), bfhi(zn[j].y)}; }
            }
        }
        VM_WAIT(); __syncthreads();
        {
            const int fr = lane & 15, fq = lane >> 4;
            f32x4 acc[2][4];
#pragma unroll
            for (int a = 0; a < 2; ++a)
#pragma unroll
                for (int b = 0; b < 4; ++b) acc[a][b] = (f32x4){0.f, 0.f, 0.f, 0.f};
            v4u fa[3][4], fb[3][8];
#define P9_LOAD(ks_, S_) do { const int kof = 256 * w + 32 * (ks_) + 8 * fq; \
                _Pragma("unroll") for (int a = 0; a < 2; ++a) { fa[S_][a] = *(const GAS v4u*)(H2HI + (size_t)(row0 + 16 * a + fr) * D + kof); fa[S_][2 + a] = *(const GAS v4u*)(H2LO + (size_t)(row0 + 16 * a + fr) * D + kof); } \
                _Pragma("unroll") for (int b = 0; b < 4; ++b) { fb[S_][b] = *(const GAS v4u*)(WRH + (size_t)(16 * b + fr) * D + kof); fb[S_][4 + b] = *(const GAS v4u*)(WRL + (size_t)(16 * b + fr) * D + kof); } } while (0)
#define P9_MMA(S_) do { \
                _Pragma("unroll") for (int a = 0; a < 2; ++a) \
                _Pragma("unroll") for (int b = 0; b < 4; ++b) { \
                    acc[a][b] = __builtin_amdgcn_mfma_f32_16x16x32_bf16(__builtin_bit_cast(bf16x8, fa[S_][a]), __builtin_bit_cast(bf16x8, fb[S_][b]), acc[a][b], 0, 0, 0); \
                    acc[a][b] = __builtin_amdgcn_mfma_f32_16x16x32_bf16(__builtin_bit_cast(bf16x8, fa[S_][2 + a]), __builtin_bit_cast(bf16x8, fb[S_][b]), acc[a][b], 0, 0, 0); \
                    acc[a][b] = __builtin_amdgcn_mfma_f32_16x16x32_bf16(__builtin_bit_cast(bf16x8, fa[S_][a]), __builtin_bit_cast(bf16x8, fb[S_][4 + b]), acc[a][b], 0, 0, 0); } } while (0)
            P9_LOAD(0, 0); P9_LOAD(1, 1);
            P9_LOAD(2, 2); P9_MMA(0);
            P9_LOAD(3, 0); P9_MMA(1);
            P9_LOAD(4, 1); P9_MMA(2);
            P9_LOAD(5, 2); P9_MMA(0);
            P9_LOAD(6, 0); P9_MMA(1);
            P9_LOAD(7, 1); P9_MMA(2);
            P9_MMA(0);
            P9_MMA(1);
#undef P9_MMA
#undef P9_LOAD
#pragma unroll
            for (int a = 0; a < 2; ++a)
#pragma unroll
                for (int b = 0; b < 4; ++b)
#pragma unroll
                    for (int i = 0; i < 4; ++i) RED[(w * 32 + 16 * a + 4 * fq + i) * 64 + 16 * b + fr] = acc[a][b][i];
        }
        __syncthreads();
        for (int idx = tid; idx < 32 * 64; idx += 512) { float s = 0.f;
#pragma unroll
            for (int ww = 0; ww < NWAVES; ++ww) s += RED[ww * 2048 + idx];
            LOG[idx] = s; }
        __syncthreads();
#pragma nounroll
        for (int q = 0; q < 4; ++q) {
            const int rl = 4 * w + q, row = row0 + rl, e = lane;
            const float aff = 1.0f / (1.0f + __expf(-LOG[rl * 64 + e]));
            const float biased = aff + F.router_bias[e];
            float v1 = biased; int i1 = e;
#pragma unroll
            for (int o = 1; o < 8; o <<= 1) { const float ov = __shfl_xor(v1, o); const int oi = __shfl_xor(i1, o); if (ov > v1 || (ov == v1 && oi < i1)) { v1 = ov; i1 = oi; } }
            float v2 = (e == i1) ? -3.0e38f : biased;
#pragma unroll
            for (int o = 1; o < 8; o <<= 1) v2 = fmaxf(v2, __shfl_xor(v2, o));
            const float gs = v1 + v2; const int mg = e >> 3;
            int grank = 0;
#pragma unroll
            for (int gp = 0; gp < 8; ++gp) { const float og = __shfl(gs, gp * 8); grank += (og > gs || (og == gs && gp < mg)) ? 1 : 0; }
            const float s = (grank < 4) ? biased : -1e30f;
            int rank = 0;
            for (int ep = 0; ep < 64; ++ep) { const float ov = __shfl(s, ep); rank += (ov > s || (ov == s && ep < e)) ? 1 : 0; }
            const bool sel = rank < TOPK;
            const float wsum = wave_sum(sel ? aff : 0.f);
            if (sel) { const int lr = __hip_atomic_fetch_add(LCNT + e, 1, __ATOMIC_RELAXED, __HIP_MEMORY_SCOPE_WORKGROUP);
                LE[rl * 8 + rank] = e; LR[rl * 8 + rank] = lr;
                SELE[(size_t)row * 8 + rank] = e; SELW[(size_t)row * 8 + rank] = aff / wsum * 2.5f; }
        }
        __syncthreads();
        if (tid < 64) LBASE[tid] = (int)__hip_atomic_fetch_add(CNT + tid, (unsigned)LCNT[tid], __ATOMIC_RELAXED, __HIP_MEMORY_SCOPE_AGENT);
        __syncthreads();
        if (tid < 256) SELR[(size_t)row0 * 8 + tid] = LBASE[LE[tid]] + LR[tid];
        __syncthreads();
    }
}

__device__ __forceinline__ void p10_tables(Frame& F) {
    unsigned char* ws = F.ws;
    const int* SELE = (const int*)(ws + WS_TAB + TB_SELE); const float* SELW = (const float*)(ws + WS_TAB + TB_SELW); const int* SELR = (const int*)(ws + WS_TAB + TB_SELR);
    int* POS = (int*)(ws + WS_TAB + TB_POS); int* TOK = (int*)(ws + WS_TAB + TB_TOK); float* WROW = (float*)(ws + WS_TAB + TB_WROW);
    unsigned* CNT = (unsigned*)(F.ctl + CW_CNT);
    LAS int* tile_e = (LAS int*)(F.lds + LX_TILE_E); LAS int* pstart = (LAS int*)(F.lds + LX_PSTART); LAS int* ntl = (LAS int*)(F.lds + LX_NTILES);
    LAS int* lcnt = (LAS int*)(F.lds + RING_OFF);
    if (F.tid < 64) {
        const int e = F.tid, c = (int)__hip_atomic_load(CNT + e, __ATOMIC_RELAXED, __HIP_MEMORY_SCOPE_AGENT), nt = (c + 255) >> 8;
        int incl = nt;
#pragma unroll
        for (int o = 1; o < 64; o <<= 1) { const int v = __shfl_up(incl, o); if (e >= o) incl += v; }
        const int before = incl - nt, total = __shfl(incl, 63);
        lcnt[e] = c; pstart[e] = before * 256;
        for (int q = 0; q < nt; ++q) tile_e[before + q] = e;
        if (e < 32) tile_e[total + e] = NE;
        if (e == 0) { pstart[NE] = total * 256; pstart[NE + 1] = (total + 32) * 256; ntl[0] = total + 32; }
    }
    __syncthreads();
    const int gt = F.bid * 512 + F.tid, NT = F.G * 512;
    for (int idx = gt; idx < T * TOPK; idx += NT) { const int e = SELE[idx], pos = pstart[e] + SELR[idx]; TOK[pos] = idx >> 3; WROW[pos] = SELW[idx]; POS[idx] = pos; }
    for (int t = gt; t < T; t += NT) { TOK[pstart[NE] + t] = t; WROW[pstart[NE] + t] = 1.0f; }
    for (int e = F.bid; e < NE; e += F.G) { const int c = lcnt[e];
        for (int s = pstart[e] + c + F.tid; s < pstart[e + 1]; s += 512) { TOK[s] = 0; WROW[s] = 0.f; } }
    __syncthreads();
}

__device__ __forceinline__ void p13_final(Frame& F) {
    unsigned char* ws = F.ws;
    const float* mod = (const float*)(ws + WS_SMALL + SM_MOD);
    const float* X1 = (const float*)(ws + WS_X1); const bf16* YB = (const bf16*)(ws + WS_YB);
    const int* POS = (const int*)(ws + WS_TAB + TB_POS);
    const LAS int* pstart = (const LAS int*)(F.lds + LX_PSTART);
    const int gw = F.bid * NWAVES + F.wave, NGW = F.G * NWAVES, lane = F.lane;
    const int shbase = pstart[NE];
    for (int row = gw; row < T; row += NGW) {
        float y[4][8];
#pragma unroll
        for (int j = 0; j < 4; ++j)
#pragma unroll
            for (int i = 0; i < 8; ++i) y[j][i] = 0.f;
        const int posv = POS[(size_t)row * 8 + (lane & 7)];
#pragma unroll
        for (int kb = 0; kb < 3; ++kb) {
            v4u w[3][4];
#pragma unroll
            for (int kk = 0; kk < 3; ++kk) { const int k = 3 * kb + kk;
                const int slot = (k < TOPK) ? __shfl(posv, k) : shbase + row;
                const bf16* yr = YB + (size_t)slot * D;
#pragma unroll
                for (int j = 0; j < 4; ++j) w[kk][j] = *(const GAS v4u*)(yr + 8 * (lane + 64 * j)); }
#pragma unroll
            for (int kk = 0; kk < 3; ++kk)
#pragma unroll
                for (int j = 0; j < 4; ++j) { float a[8]; unpack8(w[kk][j], a);
#pragma unroll
                    for (int i = 0; i < 8; ++i) y[j][i] += a[i]; }
        }
        float ss = 0.f;
#pragma unroll
        for (int j = 0; j < 4; ++j)
#pragma unroll
            for (int i = 0; i < 8; ++i) ss += y[j][i] * y[j][i];
        const float rstd = 1.0f / sqrtf(wave_sum(ss) * (1.0f / D) + RMS_EPS);
#pragma unroll
        for (int j = 0; j < 4; ++j) { const int col = 8 * (lane + 64 * j);
#pragma unroll
            for (int hh = 0; hh < 2; ++hh) {
                const f32x4 x1 = *(const GAS f32x4*)(X1 + (size_t)row * D + col + 4 * hh), g = *(const GAS f32x4*)(F.g_post_ffn + col + 4 * hh), gt = *(const GAS f32x4*)(mod + 5 * D + col + 4 * hh);
                f32x4 yy; yy.x = y[j][4 * hh]; yy.y = y[j][4 * hh + 1]; yy.z = y[j][4 * hh + 2]; yy.w = y[j][4 * hh + 3];
                *(GAS f32x4*)(F.out + (size_t)row * D + col + 4 * hh) = x1 + gt * ((yy * rstd) * g); } }
    }
}
#if defined(DIAG) && DIAG
constexpr int CW_DIAG = 5120;
__device__ __forceinline__ float wave_max(float v) {
#pragma unroll
    for (int o = 1; o < 64; o <<= 1) v = fmaxf(v, __shfl_xor(v, o));
    return v;
}
__device__ __forceinline__ float ldbf(const bf16* p) { return bf2f(*p); }
__device__ __forceinline__ void diag_max(gu32* w, float v) { if (v == v) atomicMax((unsigned*)w, __builtin_bit_cast(unsigned, fabsf(v))); else atomicMax((unsigned*)w, 0x7f000000u); }

__device__ __forceinline__ int diag_sample_t(int s) {
    const int special[32] = {0, 1, 5, 30, 31, 32, 46, 47, 48, 62, 63, 64, 65, 95, 127, 128, 200, 511, 512, 513, 575, 576, 1000, 1023, 1024, 1025, 1087, 1088, 2047, 4095, 8190, 8191};
    int t = (int)(((unsigned)s * 2654435761u) >> 19);
#pragma unroll
    for (int i = 0; i < 32; ++i) t = (s == i) ? special[i] : t;
    return t;
}

__device__ __forceinline__ void diag_cs(float pos, int i, float& c, float& sn) {
    const float inv[12] = {1.000000000e+00f, 3.350316475e-01f, 1.122462048e-01f, 3.760603093e-02f, 1.259921050e-02f, 4.221134251e-03f, 1.414213562e-03f, 4.738062997e-04f, 1.587401052e-04f, 5.318295897e-05f, 1.781797436e-05f, 5.969585306e-06f};
    float iv = inv[0];
#pragma unroll
    for (int q = 1; q < 12; ++q) iv = (i == q) ? inv[q] : iv;
    const float ang = pos * iv;
    const double a = (double)ang, k = __builtin_rint(a * 0.15915494309189535), r = a - k * 6.283185307179586;
    c = __cosf((float)r); sn = __sinf((float)r);
}
__device__ __forceinline__ void diag_attention(Frame& F) {
    unsigned char* ws = F.ws;
    const bf16* PROJ = (const bf16*)(ws + WS_PROJ); const bf16* QR = (const bf16*)(ws + WS_QR);
    const bf16* OB = (const bf16*)(ws + WS_O);
    LAS float* L = (LAS float*)(F.lds + RING_OFF + F.wave * 12288);
    LAS float* Psum = L; LAS float* pbuf = L + 512; LAS float* score = L + 1536; LAS float* self_ = L + 1664; LAS float* qv = L + 1792; LAS float* ocmp = L + 1920;
    const int gw = F.bid * NWAVES + F.wave, NGW = F.G * NWAVES, lane = F.lane;
    for (int s = gw; s < 1024; s += NGW) {
        const int t = diag_sample_t(s >> 2), g = s & 3;
        const bf16* KSG = (const bf16*)(ws + WS_KSG) + (size_t)g * T * DQK; const bf16* KWG = (const bf16*)(ws + WS_KWG) + (size_t)g * T * DQK;
        const bf16* VST = (const bf16*)(ws + WS_VST) + (size_t)g * DV * T; const bf16* VWT = (const bf16*)(ws + WS_VWT) + (size_t)g * DV * T;
        const bf16* KCR = (const bf16*)(ws + WS_KCR) + (size_t)g * NCMPP * DQK; const bf16* VCT = (const bf16*)(ws + WS_VCT) + (size_t)g * DV * NCMPP;
        for (int i = lane; i < 512; i += 64) Psum[i] = 0.f;
        LDS_WAIT();
        for (int hd = 0; hd < 4; ++hd) {
            const int hg = 4 * g + hd;
            for (int i = lane; i < DQK; i += 64) qv[i] = ldbf(QR + (size_t)t * (NH * DQK) + hg * DQK + i);
            LDS_WAIT();
            float sv[8]; float mx = -1e30f;
#pragma unroll
            for (int i = 0; i < 8; ++i) { const int n = lane + 64 * i; const bool ok = (n < NCMP) && (16 * n + 31 <= t); float d = 0.f;
                if (ok) for (int k = 0; k < DQK; ++k) d += qv[k] * ldbf(KCR + (size_t)n * DQK + k);
                sv[i] = ok ? d : -1e30f; mx = ok ? fmaxf(mx, d) : mx; }
            mx = wave_max(mx);
            float sum = 0.f;
#pragma unroll
            for (int i = 0; i < 8; ++i) { const float p = (sv[i] > -1e29f) ? exp2f(sv[i] - mx) : 0.f; sv[i] = p; sum += p; }
            sum = wave_sum(sum);
            const float inv = sum > 0.f ? 1.0f / sum : 0.f;
#pragma unroll
            for (int i = 0; i < 8; ++i) { const int n = lane + 64 * i; const float p = sv[i] * inv; pbuf[n] = p; Psum[n] += p; }
            LDS_WAIT();
            { float o = 0.f; for (int n = 0; n < NCMP; ++n) o += pbuf[n] * ldbf(VCT + (size_t)lane * NCMPP + n); ocmp[hd * 64 + lane] = o; }
            LDS_WAIT();
        }
        const int cur = t >> 6;
        for (int j = lane; j < NSLC; j += 64) {
            float imp = 0.f;
            for (int n = 0; n < NCMP; ++n) { const int lo = 16 * n, hi = lo + 32; int a = lo > 64 * j ? lo : 64 * j, b = hi < 64 * j + 64 ? hi : 64 * j + 64; const int ov = b - a; if (ov > 0) imp += Psum[n] * ((float)ov * (1.0f / 32.0f)); }
            const bool valid = (j * 64 <= t), forced = (j == 0) || (j == cur) || (j == cur - 1);
            score[j] = valid ? (forced ? 1e30f : imp) : -1e30f;
        }
        LDS_WAIT();
        for (int j = lane; j < NSLC; j += 64) { int rank = 0; const float sj = score[j];
            for (int jp = 0; jp < NSLC; ++jp) { const float v = score[jp]; rank += (v > sj || (v == sj && jp < j)) ? 1 : 0; }
            self_[j] = (rank < NSEL && sj > -0.5e30f) ? 1.f : 0.f; }
        LDS_WAIT();
        for (int hd = 0; hd < 4; ++hd) {
            const int hg = 4 * g + hd;
            for (int i = lane; i < DQK; i += 64) qv[i] = ldbf(QR + (size_t)t * (NH * DQK) + hg * DQK + i);
            LDS_WAIT();
            float oslc = 0.f;
            { float mx = -1e30f; int nb = 0;
              for (int j = 0; j < NSLC; ++j) { if (self_[j] == 0.f) continue; const int kp = 64 * j + lane; float d = -1e30f;
                  if (kp <= t) { d = 0.f; for (int k = 0; k < DQK; ++k) d += qv[k] * ldbf(KSG + (size_t)kp * DQK + k); mx = fmaxf(mx, d); }
                  pbuf[nb * 64 + lane] = d; ++nb; }
              mx = wave_max(mx);
              float sum = 0.f;
              for (int b = 0; b < nb; ++b) { const float d = pbuf[b * 64 + lane]; const float p = (d > -1e29f) ? exp2f(d - mx) : 0.f; pbuf[b * 64 + lane] = p; sum += p; }
              sum = wave_sum(sum);
              LDS_WAIT();
              int b = 0;
              for (int j = 0; j < NSLC; ++j) { if (self_[j] == 0.f) continue;
                  for (int kk = 0; kk < 64; ++kk) oslc += pbuf[b * 64 + kk] * ldbf(VST + (size_t)lane * T + 64 * j + kk);
                  ++b; }
              oslc = sum > 0.f ? oslc / sum : 0.f; }
            LDS_WAIT();
            float owin = 0.f;
            { float mx = -1e30f;
              for (int i = 0; i < 8; ++i) { const int kp = t - 511 + 64 * i + lane; float d = -1e30f;
                  if (kp >= 0 && kp <= t) { d = 0.f; for (int k = 0; k < DQK; ++k) d += qv[k] * ldbf(KWG + (size_t)kp * DQK + k); mx = fmaxf(mx, d); }
                  pbuf[i * 64 + lane] = d; }
              mx = wave_max(mx);
              float sum = 0.f;
              for (int i = 0; i < 8; ++i) { const float d = pbuf[i * 64 + lane]; const float p = (d > -1e29f) ? exp2f(d - mx) : 0.f; pbuf[i * 64 + lane] = p; sum += p; }
              sum = wave_sum(sum);
              LDS_WAIT();
              for (int i = 0; i < 512; ++i) { const int kp = t - 511 + i; if (kp >= 0) owin += pbuf[i] * ldbf(VWT + (size_t)lane * T + kp); }
              owin = sum > 0.f ? owin / sum : 0.f; }
            const float g0 = sigmoidf_(ldbf(PROJ + (size_t)t * NP + C_GN + hg * 3 + 0)), g1 = sigmoidf_(ldbf(PROJ + (size_t)t * NP + C_GN + hg * 3 + 1)), g2 = sigmoidf_(ldbf(PROJ + (size_t)t * NP + C_GN + hg * 3 + 2));
            const float ref = g0 * ocmp[hd * 64 + lane] + g1 * oslc + g2 * owin;
            const float got = ldbf(OB + (size_t)t * 1024 + hg * DV + lane);
            const float df = wave_max(fabsf(got - ref) == fabsf(got - ref) ? fabsf(got - ref) : 3e38f), rf = wave_max(fabsf(ref));
            if (lane == 0) { diag_max(F.ctl + CW_DIAG + 0, df / fmaxf(rf, 1e-6f)); diag_max(F.ctl + CW_DIAG + 1, rf); }
            LDS_WAIT();
        }
    }
}
__device__ __forceinline__ void diag_rope_cmp(Frame& F) {
    unsigned char* ws = F.ws;
    const bf16* PROJ = (const bf16*)(ws + WS_PROJ); const bf16* QR = (const bf16*)(ws + WS_QR);
    const bf16* KSG = (const bf16*)(ws + WS_KSG); const bf16* KWG = (const bf16*)(ws + WS_KWG); const bf16* KCG = (const bf16*)(ws + WS_KCG); const bf16* VCG = (const bf16*)(ws + WS_VCG);
    const bf16* KCR = (const bf16*)(ws + WS_KCR); const bf16* VCT = (const bf16*)(ws + WS_VCT);
    const bf16* VST = (const bf16*)(ws + WS_VST); const bf16* VWT = (const bf16*)(ws + WS_VWT);
    const int gw = F.bid * NWAVES + F.wave, NGW = F.G * NWAVES, lane = F.lane;
    LAS float* hid = (LAS float*)(F.lds + RING_OFF + F.wave * 12288);
    LAS float* ov = hid + 384;
    for (int s = gw; s < 256; s += NGW) {
        const int t = diag_sample_t(s); const float pos = (float)F.positions[t];
        float md = 0.f;
        for (int idx = lane; idx < (NH + 2 * NG) * DQK; idx += 64) {
            const int hh = idx / DQK, d = idx % DQK;
            const bf16* src; const bf16* dst; float scale = 1.0f;
            if (hh < NH) { src = PROJ + (size_t)t * NP + C_Q + hh * DQK; dst = QR + (size_t)t * (NH * DQK) + hh * DQK; scale = 0.14724444236568886f; }
            else if (hh < NH + NG) { const int g = hh - NH; src = PROJ + (size_t)t * NP + C_KS + g * DQK; dst = KSG + ((size_t)g * T + t) * DQK; }
            else { const int g = hh - NH - NG; src = PROJ + (size_t)t * NP + C_KW + g * DQK; dst = KWG + ((size_t)g * T + t) * DQK; }
            float ref;
            if (d < ROT) { const int i = d % HALFROT; float c, sn; diag_cs(pos, i, c, sn);
                const float x1 = ldbf(src + i), x2 = ldbf(src + HALFROT + i); ref = (d < HALFROT) ? (x1 * c - x2 * sn) : (x2 * c + x1 * sn); }
            else ref = ldbf(src + d);
            ref *= scale;
            md = fmaxf(md, fabsf(ldbf(dst + d) - ref));
        }
        for (int idx = lane; idx < NG * DV; idx += 64) { const int g = idx / DV, dv = idx % DV;
            md = fmaxf(md, fabsf(ldbf(VST + ((size_t)g * DV + dv) * T + t) - ldbf(PROJ + (size_t)t * NP + C_VS + idx)));
            md = fmaxf(md, fabsf(ldbf(VWT + ((size_t)g * DV + dv) * T + t) - ldbf(PROJ + (size_t)t * NP + C_VW + idx)));
            md = fmaxf(md, fabsf(ldbf(VCG + ((size_t)g * T + t) * DV + dv) - ldbf(PROJ + (size_t)t * NP + C_VC + idx))); }
        for (int idx = lane; idx < NG * DQK; idx += 64) { const int g = idx / DQK, d = idx % DQK;
            md = fmaxf(md, fabsf(ldbf(KCG + ((size_t)g * T + t) * DQK + d) - ldbf(PROJ + (size_t)t * NP + C_KC + idx))); }
        md = wave_max(md);
        if (lane == 0) diag_max(F.ctl + CW_DIAG + 2, md);
    }
    for (int s = gw; s < 128; s += NGW) {
        const int g = s & 3; int n = (int)(((unsigned)(s >> 2) * 2654435761u) >> 23) % NCMP; if ((s >> 2) == 0) n = 0; if ((s >> 2) == 1) n = NCMP - 1;
        for (int c = lane; c < 384; c += 64) { float a = 0.f;
            for (int l = 0; l < 32; ++l) for (int d = 0; d < DQK; ++d) a += (ldbf(KCG + ((size_t)g * T + 16 * n + l) * DQK + d) + F.cmp_pos_k[l * DQK + d]) * F.cmp_k_w1[(size_t)(l * DQK + d) * 384 + c];
            hid[c] = a / (1.0f + __expf(-a)); }
        LDS_WAIT();
        for (int j = lane; j < DQK; j += 64) { float a = 0.f; for (int c = 0; c < 384; ++c) a += hid[c] * F.cmp_k_w2[c * DQK + j]; ov[j] = a; }
        LDS_WAIT();
        float md = 0.f, mr = 0.f;
        { const float pos = (float)F.positions[16 * n + 31];
          for (int j = lane; j < DQK; j += 64) { float ref = ov[j];
              if (j < ROT) { const int i = j % HALFROT; float c, sn; diag_cs(pos, i, c, sn);
                  ref = (j < HALFROT) ? (ov[i] * c - ov[HALFROT + i] * sn) : (ov[HALFROT + i] * c + ov[i] * sn); }
              md = fmaxf(md, fabsf(ldbf(KCR + ((size_t)g * NCMPP + n) * DQK + j) - ref)); mr = fmaxf(mr, fabsf(ref)); } }
        LDS_WAIT();
        for (int c = lane; c < 256; c += 64) { float a = 0.f;
            for (int l = 0; l < 32; ++l) for (int d = 0; d < DV; ++d) a += (ldbf(VCG + ((size_t)g * T + 16 * n + l) * DV + d) + F.cmp_pos_v[l * DV + d]) * F.cmp_v_w1[(size_t)(l * DV + d) * 256 + c];
            hid[c] = a / (1.0f + __expf(-a)); }
        LDS_WAIT();
        { float a = 0.f; for (int c = 0; c < 256; ++c) a += hid[c] * F.cmp_v_w2[c * DV + lane];
          md = fmaxf(md, fabsf(ldbf(VCT + ((size_t)g * DV + lane) * NCMPP + n) - a)); mr = fmaxf(mr, fabsf(a)); }
        LDS_WAIT();
        md = wave_max(md); mr = wave_max(mr);
        if (lane == 0) { diag_max(F.ctl + CW_DIAG + 3, md / fmaxf(mr, 1e-6f)); diag_max(F.ctl + CW_DIAG + 4, mr); }
    }
}
#endif
struct Args { const void* in[29]; float* out; unsigned char* ws; };
__global__ void __launch_bounds__(NWAVES * 64, 2) fwd_kernel(Args args) {
    extern __shared__ __attribute__((aligned(16))) unsigned char lds[];
    Frame F;
    F.lds = (LAS unsigned char*)lds;
    F.MISC = (volatile LAS unsigned*)(F.lds + MISC_OFF);
    F.tid = threadIdx.x; F.lane = F.tid & 63; F.wave = __builtin_amdgcn_readfirstlane(F.tid >> 6);
    F.G = gridDim.x; F.bid = blockIdx.x;
    unsigned char* ws = args.ws; F.ws = ws;
    F.ctl = (gu32*)(ws + WS_CTL);
    F.x = (const float*)args.in[0]; F.c = (const float*)args.in[1]; F.positions = (const int*)args.in[2];
    F.w_ada = (const float*)args.in[3]; F.b_ada = (const float*)args.in[4];
    F.g_pre_mix = (const float*)args.in[5]; F.g_post_mix = (const float*)args.in[6]; F.g_pre_ffn = (const float*)args.in[7]; F.g_post_ffn = (const float*)args.in[8];
    F.w_in = (const float*)args.in[9];
    F.cmp_pos_k = (const float*)args.in[10]; F.cmp_k_w1 = (const float*)args.in[11]; F.cmp_k_w2 = (const float*)args.in[12];
    F.cmp_pos_v = (const float*)args.in[13]; F.cmp_v_w1 = (const float*)args.in[14]; F.cmp_v_w2 = (const float*)args.in[15];
    F.pool_w = (const float*)args.in[16]; F.pool_scale = (const float*)args.in[17];
    F.w_pool_up = (const float*)args.in[18]; F.w_nsa_up = (const float*)args.in[19]; F.w_out = (const float*)args.in[20];
    F.w_router = (const float*)args.in[21]; F.router_bias = (const float*)args.in[22];
    F.w_exp_gate = (const float*)args.in[23]; F.w_exp_up = (const float*)args.in[24]; F.w_exp_down = (const float*)args.in[25];
    F.w_sh_gate = (const float*)args.in[26]; F.w_sh_up = (const float*)args.in[27]; F.w_sh_down = (const float*)args.in[28];
    F.out = args.out;
    for (int u = F.tid; u < (LDS_BYTES - LDSCTL_OFF) / 4; u += NWAVES * 64) ((LAS unsigned*)(F.lds + LDSCTL_OFF))[u] = 0u;
    __syncthreads();
    XcdBarrier bar = xcd_barrier_post((unsigned*)(F.ctl + CW_BAR), F.MISC + 8);
#define GRID_BAR() do { xcd_barrier(bar); TSTAMP(); int _t = threadIdx.x; asm volatile("" : "+v"(_t)); F.tid = _t; F.lane = _t & 63; F.wave = __builtin_amdgcn_readfirstlane(_t >> 6); } while (0)
    LAS unsigned char* ring = F.lds + RING_OFF;
#if defined(TIMEPH)
    int n_ts = 0; unsigned long long ts_prev = __builtin_amdgcn_s_memrealtime(); float ts_sel = 0.f;
#define TSTAMP() do { const unsigned long long _n = __builtin_amdgcn_s_memrealtime(); if (n_ts == TIMEPH || TIMEPH == 99) ts_sel += (float)(_n - ts_prev) * 0.01f; ts_prev = _n; ++n_ts; } while (0)
#else
#define TSTAMP() do { } while (0)
#endif
    const int vcu = (F.G % 8 == 0) ? (F.bid % 8) * (F.G / 8) + F.bid / 8 : F.bid;

#if PH_HI > 0 && PH_LO <= 0
    for (int rep_ = 0; rep_ < ((REP_PHASE == 0) ? 1 + REP_EXTRA : 1); ++rep_) {
    p0_prologue(F);
    conv_pull(F, CONV_P0);
    GRID_BAR();
    }
#endif
#if PH_HI > 1 && PH_LO <= 1
    for (int rep_ = 0; rep_ < ((REP_PHASE == 1) ? 1 + REP_EXTRA : 1); ++rep_) {
    p1_norm(F);
    GRID_BAR();
    }
#endif
#if PH_HI > 2 && PH_LO <= 2
    for (int rep_ = 0; rep_ < ((REP_PHASE == 2) ? 1 + REP_EXTRA : 1); ++rep_) {
    {
        pg8::Gemm g{(const bf16*)(ws + WS_H), 2048, 2048};
        SchedPlain S{32, 32, F.G, F.bid, (const char*)(ws + WS_WIN), 4096u, 4096};
        EpiBf16 E{(bf16*)(ws + WS_PROJ), NP, 0, 0};
        pg8::gemm_phase<EpiBf16, SchedPlain>(ring, g, S, E);
    }
    GRID_BAR();
    }
#endif
#if PH_HI > 3 && PH_LO <= 3
    for (int rep_ = 0; rep_ < ((REP_PHASE == 3) ? 1 + REP_EXTRA : 1); ++rep_) {
    {
        const bool split = (F.G == 256);
        const bool tailer = split ? ((F.bid & 3) == 0) : (F.bid < 64);
        pg8::Gemm g{(const bf16*)(ws + WS_H), 2048, 2048};
        SchedInTail S{tailer ? (split ? (F.bid >> 2) : F.bid) : -1, (const char*)(ws + WS_WIN), 4096u, 4096}; EpiBf16 E{(bf16*)(ws + WS_PROJ), NP, 0, 0};
        pg8::gemm_phase<EpiBf16, SchedInTail>(ring, g, S, E);
        if (!split) { __syncthreads(); p3_relayout(F, F.bid, F.G); }
        else if (!tailer) p3_relayout(F, F.bid - (F.bid >> 2) - 1, 192);
    }
    GRID_BAR();
    }
#endif
#if PH_HI > 4 && PH_LO <= 4
    for (int rep_ = 0; rep_ < ((REP_PHASE == 4) ? 1 + REP_EXTRA : 1); ++rep_) {
    {
        pg8::Gemm g{(const bf16*)(ws + WS_DPOOL), 256, 256};
        SchedPool S{F.G, F.bid, (const char*)(ws + WS_WPOOL)};
        EpiBf16 E{(bf16*)(ws + WS_APOOL), 1024, 0, 256};
        pg8::gemm_phase<EpiBf16, SchedPool>(ring, g, S, E);
    }
    {
        pg8::Gemm g{(const bf16*)(ws + WS_KCG), 3072, 768};
        SchedSplitK S{2, F.G, (F.bid + F.G - 128 % F.G) % F.G, (const char*)(ws + WS_WCK), 3072u, 6144, 768};
        EpiF32 E{(float*)(ws + WS_PARTK), 512, (size_t)2048 * 512};
        pg8::gemm_phase<EpiF32, SchedSplitK>(ring, g, S, E);
    }
    {
        pg8::Gemm g{(const bf16*)(ws + WS_VCG), 2048, 512};
        SchedSplitK S{1, F.G, (F.bid + F.G - 192 % F.G) % F.G, (const char*)(ws + WS_WCV), 2048u, 4096, 512};
        EpiF32 E{(float*)(ws + WS_PARTV), 256, (size_t)2048 * 256};
        pg8::gemm_phase<EpiF32, SchedSplitK>(ring, g, S, E);
    }
    GRID_BAR();
    }
#endif
#if PH_HI > 5 && PH_LO <= 5
    for (int rep_ = 0; rep_ < ((REP_PHASE == 5) ? 1 + REP_EXTRA : 1); ++rep_) {
    p5_cmp2(F);
    __syncthreads();
#ifdef CMP2_TWICE
    p5_cmp2(F);
    __syncthreads();
#endif
#ifdef P5_SPLIT
    TSTAMP();
#endif
    {
        pg8::Gemm g{(const bf16*)(ws + WS_APOOL), 1024, 1024};
        SchedPlain S{32, 8, F.G, F.bid, (const char*)(ws + WS_WPU), 2048u, 2048};
        EpiGate<false> E{(bf16*)(ws + WS_YPART), nullptr, (const bf16*)(ws + WS_PROJ), C_GM};
        pg8::gemm_phase<EpiGate<false>, SchedPlain>(ring, g, S, E);
#ifdef YA_TWICE
        __syncthreads();
        pg8::gemm_phase<EpiGate<false>, SchedPlain>(ring, g, S, E);
#endif
    }
    GRID_BAR();
    }
#endif
#if PH_HI > 6 && PH_LO <= 6
    for (int rep_ = 0; rep_ < ((REP_PHASE == 6) ? 1 + REP_EXTRA : 1); ++rep_) {
    nsa::p6_attention(F);
    GRID_BAR();
    }
#endif
#if defined(DIAG) && DIAG
    diag_attention(F);
    __syncthreads();
    diag_rope_cmp(F);
    GRID_BAR();
#endif
#if PH_HI > 7 && PH_LO <= 7
    for (int rep_ = 0; rep_ < ((REP_PHASE == 7) ? 1 + REP_EXTRA : 1); ++rep_) {
    {
        pg8::Gemm g{(const bf16*)(ws + WS_O), 1024, 1024};
        SchedPlain S{32, 8, F.G, F.bid, (const char*)(ws + WS_WNU), 2048u, 2048};
        EpiGate<true> E{(bf16*)(ws + WS_Y), (const bf16*)(ws + WS_YPART), (const bf16*)(ws + WS_PROJ), C_GM + 2048};
        pg8::gemm_phase<EpiGate<true>, SchedPlain>(ring, g, S, E);
    }
    GRID_BAR();
    }
#endif
#if PH_HI > 8 && PH_LO <= 8
    for (int rep_ = 0; rep_ < ((REP_PHASE == 8) ? 1 + REP_EXTRA : 1); ++rep_) {
    {
        pg8::Gemm g{(const bf16*)(ws + WS_Y), 2048, 2048};
        SchedPlain S{32, 8, F.G, F.bid, (const char*)(ws + WS_WOUT), 4096u, 4096};
        EpiBf16 E{(bf16*)(ws + WS_Z), 2048, 0, 0};
        pg8::gemm_phase<EpiBf16, SchedPlain>(ring, g, S, E);
    }
    GRID_BAR();
    }
#endif
#if PH_HI > 9 && PH_LO <= 9
    for (int rep_ = 0; rep_ < ((REP_PHASE == 9) ? 1 + REP_EXTRA : 1); ++rep_) {
    p9_post_router(F);
    GRID_BAR();
    }
#endif
#if PH_HI > 10 && PH_LO <= 10
    for (int rep_ = 0; rep_ < ((REP_PHASE == 10) ? 1 + REP_EXTRA : 1); ++rep_) {
    __syncthreads();
    conv_pull(F, 1 << 20);
    __syncthreads();
    p10_tables(F);
    GRID_BAR();
    }
#endif
#if PH_HI > 11 && PH_LO <= 11
    for (int rep_ = 0; rep_ < ((REP_PHASE == 11) ? 1 + REP_EXTRA : 1); ++rep_) {
    {
        const LAS int* tile_e = (const LAS int*)(F.lds + LX_TILE_E); const int ntiles = *(const LAS int*)(F.lds + LX_NTILES);
        pg8::Gemm g{(const bf16*)(ws + WS_H2HI), 2048, 2048};
        SchedMoe1 S{F.G, P11_C, ntiles, tile_e, (const int*)(ws + WS_TAB + TB_TOK), (const char*)(ws + WS_W1)};
        EpiMoe1 E{(bf16*)(ws + WS_HID), (const float*)(ws + WS_TAB + TB_WROW)};
        pg8::gemm_phase<EpiMoe1, SchedMoe1>(ring, g, S, E);
    }
    GRID_BAR();
    }
#endif
#if PH_HI > 12 && PH_LO <= 12
    for (int rep_ = 0; rep_ < ((REP_PHASE == 12) ? 1 + REP_EXTRA : 1); ++rep_) {
    {
        const LAS int* tile_e = (const LAS int*)(F.lds + LX_TILE_E); const int ntiles = *(const LAS int*)(F.lds + LX_NTILES);
        pg8::Gemm g{(const bf16*)(ws + WS_HID), 512, 512};
        SchedMoe2 S{F.G, vcu, ntiles, tile_e, (const char*)(ws + WS_W2)};
        EpiBf16 E{(bf16*)(ws + WS_YB), 2048, 0, 0};
        pg8::gemm_phase<EpiBf16, SchedMoe2>(ring, g, S, E);
    }
    GRID_BAR();
    }
#endif
#ifdef EXTRA_BARS
    for (int eb = 0; eb < 10; ++eb) GRID_BAR();
#endif
#if PH_HI > 13 && PH_LO <= 13
    for (int rep_ = 0; rep_ < ((REP_PHASE == 13) ? 1 + REP_EXTRA : 1); ++rep_) {
    p13_final(F);
#if defined(TIMEPH)
    TSTAMP();
    VM_WAIT(); __syncthreads();
    if (F.bid == 0 && F.tid == 0) F.out[4096] = 10.0f + ts_sel * TSCALE;
#endif
#if defined(DIAG) && DIAG
    VM_WAIT(); __syncthreads();
    if (F.bid == 0 && F.tid == 0) {
        const float ad = __builtin_bit_cast(float, __hip_atomic_load(F.ctl + CW_DIAG + 0, RLX_AGENT)), ar = __builtin_bit_cast(float, __hip_atomic_load(F.ctl + CW_DIAG + 1, RLX_AGENT));
        const float rd = __builtin_bit_cast(float, __hip_atomic_load(F.ctl + CW_DIAG + 2, RLX_AGENT));
        const float cd = __builtin_bit_cast(float, __hip_atomic_load(F.ctl + CW_DIAG + 3, RLX_AGENT)), cr = __builtin_bit_cast(float, __hip_atomic_load(F.ctl + CW_DIAG + 4, RLX_AGENT));
        float e = 0.f;
        if (DIAG & 1) e = fmaxf(e, ad);
        if (DIAG & 2) e = fmaxf(e, rd);
        if (DIAG & 4) e = fmaxf(e, cd);
        if (DIAG & 8) e = ar;
        if (DIAG & 16) e = cr;
        asm volatile("s_waitcnt vmcnt(0)" ::: "memory");
        F.out[4096] = 10.0f + 1000.0f * e;
    }
#endif
    }
#endif
}

extern "C" void kernel_launch(void* const* d_in, const int* in_sizes, int n_in, void* d_out, int out_size, void* d_ws, size_t ws_size, hipStream_t stream) {
    static int grid = 0;
    if (grid == 0) {
        if (n_in != 29 || in_sizes[0] != T * D || out_size != T * D || ws_size < WS_END) { fprintf(stderr, "kernel_launch: unexpected shapes (n_in %d, in0 %d, out %d, ws %zu, need %zu)\n", n_in, n_in > 0 ? in_sizes[0] : -1, out_size, ws_size, (size_t)WS_END); grid = -1; return; }
        int dev = 0, cus = 0, per_cu = 0;
        if (hipGetDevice(&dev) != hipSuccess || hipDeviceGetAttribute(&cus, hipDeviceAttributeMultiprocessorCount, dev) != hipSuccess) { grid = -1; return; }
        if (hipFuncSetAttribute((const void*)fwd_kernel, hipFuncAttributeMaxDynamicSharedMemorySize, LDS_BYTES) != hipSuccess) { fprintf(stderr, "kernel_launch: hipFuncSetAttribute failed\n"); grid = -1; return; }
        if (hipOccupancyMaxActiveBlocksPerMultiprocessor(&per_cu, (const void*)fwd_kernel, NWAVES * 64, LDS_BYTES) != hipSuccess || per_cu < 1) { fprintf(stderr, "kernel_launch: occupancy query reports %d\n", per_cu); }
        (void)hipGetLastError();
        grid = cus;
    }
    if (grid < 0) return;
    if (hipMemsetAsync((char*)d_ws + WS_CTL, 0, CTL_ZERO_BYTES, stream) != hipSuccess) return;
    Args a{};
    for (int i = 0; i < 29; ++i) a.in[i] = d_in[i];
    a.out = (float*)d_out; a.ws = (unsigned char*)d_ws;
    hipLaunchKernelGGL(fwd_kernel, dim3(grid), dim3(NWAVES * 64), LDS_BYTES, stream, a);
}
```
